# Optimizing an MI355X kernel written in HIP

```python
import math
import jax, jax.numpy as jnp
from jax import lax
import numpy as np

D_MODEL = 1024
BATCH = 32
SEQ = 2048
DEPTH = 4

RET_HEADS = 4
RET_QK_DIM = 32
RET_V_DIM = 64
RET_CHUNK = 128
RET_QK_WIDTH = RET_HEADS * RET_QK_DIM
RET_V_WIDTH = RET_HEADS * RET_V_DIM
ROPE_BASE = 10000.0
GMLP_GROUPS = 4
GMLP_GROUP_CH = 64
GMLP_WIDTH = GMLP_GROUPS * GMLP_GROUP_CH
GMLP_CHUNK = 128
CONV_WIDTH = 256
CONV_K = 3
N_BRANCH = 3
BRANCH_WIDTH = 256
GATE_RANK = 128
IN_SPLITS = [RET_QK_WIDTH, RET_QK_WIDTH, RET_V_WIDTH, RET_V_WIDTH,
             GMLP_WIDTH, GMLP_WIDTH,
             CONV_WIDTH, CONV_WIDTH, CONV_WIDTH,
             N_BRANCH * GATE_RANK]
IN_WIDTH = sum(IN_SPLITS)
N_EXPERTS = 32
TOP_K = 4
D_FF = 256
SWIGLU_LIMIT = 7.0
SWIGLU_ALPHA = 1.702
MOE_BLOCK = 512
DEEPNORM_ALPHA = (2.0 * DEPTH) ** 0.25
DEEPNORM_BETA = (8.0 * DEPTH) ** -0.25
LN_EPS = 1e-5

kernel_name = "hybrid_retention_gmlp_shortconv_moe_deepnorm"


def _layernorm(x, g, b):
    xf = x.astype(jnp.float32)
    mu = jnp.mean(xf, axis=-1, keepdims=True)
    var = jnp.mean(jnp.square(xf - mu), axis=-1, keepdims=True)
    y = (xf - mu) * lax.rsqrt(var + LN_EPS) * g.astype(jnp.float32) + b.astype(jnp.float32)
    return y.astype(x.dtype)


def _rotary(t, positions):
    dh = t.shape[-1]
    inv_freq = ROPE_BASE ** (-jnp.arange(0, dh, 2, dtype=jnp.float32) / dh)
    ang = positions.astype(jnp.float32)[..., None] * inv_freq
    cos = jnp.cos(ang)[:, :, None, :]
    sin = jnp.sin(ang)[:, :, None, :]
    t1, t2 = jnp.split(t, 2, axis=-1)
    return jnp.concatenate([t1 * cos - t2 * sin, t2 * cos + t1 * sin], axis=-1)


def _retention(q, k, v, g, positions):
    out_dtype = v.dtype
    bsz, seq, _ = q.shape
    n_chunks = seq // RET_CHUNK
    f32 = jnp.float32
    q = _rotary(q.astype(f32).reshape(bsz, seq, RET_HEADS, RET_QK_DIM), positions)
    k = _rotary(k.astype(f32).reshape(bsz, seq, RET_HEADS, RET_QK_DIM), positions) * (RET_QK_DIM ** -0.5)
    v = v.astype(f32).reshape(bsz, seq, RET_HEADS, RET_V_DIM)
    qc = q.reshape(bsz, n_chunks, RET_CHUNK, RET_HEADS, RET_QK_DIM)
    kc = k.reshape(bsz, n_chunks, RET_CHUNK, RET_HEADS, RET_QK_DIM)
    vc = v.reshape(bsz, n_chunks, RET_CHUNK, RET_HEADS, RET_V_DIM)

    log_gamma = jnp.log(1.0 - 2.0 ** (-5.0 - jnp.arange(RET_HEADS, dtype=f32)))
    idx = jnp.arange(RET_CHUNK, dtype=f32)
    diff = idx[:, None] - idx[None, :]
    decay_mask = jnp.where(diff[None] >= 0,
                           jnp.exp(log_gamma[:, None, None] * jnp.maximum(diff, 0.0)[None]),
                           0.0)
    scores = jnp.einsum('bnchk,bnmhk->bnhcm', qc, kc) * decay_mask[None, None]
    o_intra = jnp.einsum('bnhcm,bnmhv->bnchv', scores, vc)
    zeta = jnp.exp(log_gamma[:, None] * (RET_CHUNK - 1.0 - idx)[None])
    kv = jnp.einsum('bnmhk,bnmhv,hm->bnhkv', kc, vc, zeta)
    chunk_decay = jnp.exp(log_gamma * RET_CHUNK)[None, :, None, None]
    kv_t = jnp.moveaxis(kv, 1, 0)

    def step(state, kv_n):
        return state * chunk_decay + kv_n, state

    _, r_prev = lax.scan(step, jnp.zeros_like(kv_t[0]), kv_t)
    r_prev = jnp.moveaxis(r_prev, 0, 1)
    xi = jnp.exp(log_gamma[:, None] * (idx + 1.0)[None]).T
    o_cross = jnp.einsum('bnchk,bnhkv->bnchv', qc, r_prev) * xi[None, None, :, :, None]
    o = (o_intra + o_cross).reshape(bsz, seq, RET_HEADS, RET_V_DIM)
    mu = jnp.mean(o, axis=-1, keepdims=True)
    var = jnp.mean(jnp.square(o - mu), axis=-1, keepdims=True)
    o = ((o - mu) * lax.rsqrt(var + LN_EPS)).reshape(bsz, seq, RET_V_WIDTH)
    return (jax.nn.silu(g.astype(f32)) * o).astype(out_dtype)


def _gmlp_spatial(zu, zv, ln_g, ln_b, w_spatial, b_spatial):
    bsz, seq, _ = zu.shape
    n_chunks = seq // GMLP_CHUNK
    u = jax.nn.gelu(zu)
    v = _layernorm(jax.nn.gelu(zv), ln_g, ln_b)
    vc = v.reshape(bsz, n_chunks, GMLP_CHUNK, GMLP_GROUPS, GMLP_GROUP_CH)
    causal = jnp.tril(jnp.ones((GMLP_CHUNK, GMLP_CHUNK), dtype=w_spatial.dtype))
    w_masked = w_spatial * causal[None]
    z = jnp.einsum('gcm,bnmgx->bncgx', w_masked, vc) + b_spatial.T[None, None, :, :, None]
    return u * z.reshape(bsz, seq, GMLP_WIDTH).astype(u.dtype)


def _short_conv(gate_b, gate_c, xin, conv_w):
    z = gate_c * xin
    rhs = conv_w.astype(z.dtype)[:, None, :]
    conv = lax.conv_general_dilated(z, rhs, window_strides=(1,), padding=[(CONV_K - 1, 0)],
                                    dimension_numbers=('NWC', 'WIO', 'NWC'),
                                    feature_group_count=CONV_WIDTH)
    return gate_b * conv


def _hybrid_mixer(h, positions, w_in, gmlp_ln_g, gmlp_ln_b, w_spatial, b_spatial,
                  conv_w, w_branch, w_gate_up, b_gate, w_out):
    bsz, seq, _ = h.shape
    proj = h @ w_in
    offs = [int(o) for o in np.cumsum(IN_SPLITS)[:-1]]
    (rq, rk, rv, rg, gu, gv, cb, cc, cx, gate_code) = jnp.split(proj, offs, axis=-1)
    r = _retention(rq, rk, rv, rg, positions)
    s = _gmlp_spatial(gu, gv, gmlp_ln_g, gmlp_ln_b, w_spatial, b_spatial)
    k = _short_conv(cb, cc, cx, conv_w)
    branches = jnp.stack([r, s.astype(r.dtype), k.astype(r.dtype)], axis=2)
    y = jnp.einsum('bsnw,nwd->bsnd', branches, w_branch)
    gate_code = gate_code.reshape(bsz, seq, N_BRANCH, GATE_RANK)
    g = jax.nn.sigmoid(jnp.einsum('bsnr,nrd->bsnd', gate_code, w_gate_up) + b_gate)
    merged = jnp.sum(g * y, axis=2)
    return merged @ w_out


def _moe(h, w_router, b_router, w_gu, b_gu, w_down, b_down):
    bsz, seq, d = h.shape
    n_tok = bsz * seq
    n_asg = n_tok * TOP_K
    n_blocks = n_asg // MOE_BLOCK + N_EXPERTS
    n_rows = n_blocks * MOE_BLOCK
    ht = h.reshape(n_tok, d)
    logits = (ht @ w_router + b_router).astype(jnp.float32)
    top_v, top_i = lax.top_k(logits, TOP_K)
    weights = jax.nn.softmax(top_v, axis=-1)
    flat_e = top_i.reshape(-1).astype(jnp.int32)
    order = jnp.argsort(flat_e)
    e_sorted = flat_e[order]
    tok_sorted = (order // TOP_K).astype(jnp.int32)
    w_sorted = weights.reshape(-1)[order]
    sizes = jnp.bincount(flat_e, length=N_EXPERTS).astype(jnp.int32)
    start = jnp.cumsum(sizes) - sizes
    pad_sizes = (sizes + MOE_BLOCK - 1) // MOE_BLOCK * MOE_BLOCK
    pad_end = jnp.cumsum(pad_sizes)
    pad_start = pad_end - pad_sizes
    dest = pad_start[e_sorted] + jnp.arange(n_asg, dtype=jnp.int32) - start[e_sorted]
    row_tok = jnp.full((n_rows,), n_tok, dtype=jnp.int32).at[dest].set(tok_sorted)
    row_w = jnp.zeros((n_rows,), jnp.float32).at[dest].set(w_sorted)
    block_start = jnp.arange(n_blocks, dtype=jnp.int32) * MOE_BLOCK
    block_e = jnp.minimum(jnp.searchsorted(pad_end, block_start, side='right'),
                          N_EXPERTS - 1).astype(jnp.int32)
    h_pad = jnp.concatenate([ht, jnp.zeros((1, d), ht.dtype)], axis=0)
    xs = h_pad[row_tok].reshape(n_blocks, MOE_BLOCK, d).astype(w_gu.dtype)
    gu = jnp.einsum('nmd,ndf->nmf', xs, w_gu[block_e]) + b_gu[block_e][:, None, :]
    gate = jnp.minimum(gu[..., :D_FF], SWIGLU_LIMIT)
    up = jnp.clip(gu[..., D_FF:], -SWIGLU_LIMIT, SWIGLU_LIMIT)
    act = (up + 1.0) * (gate * jax.nn.sigmoid(SWIGLU_ALPHA * gate))
    out = jnp.einsum('nmf,nfd->nmd', act.astype(w_down.dtype), w_down[block_e]) + b_down[block_e][:, None, :]
    out = out.reshape(n_rows, d).astype(jnp.float32) * row_w[:, None]
    y = jax.ops.segment_sum(out, row_tok, num_segments=n_tok + 1)[:n_tok]
    return y.reshape(bsz, seq, d).astype(h.dtype)


def setup_inputs(seed: int = 0) -> dict:
    key = jax.random.key(seed)
    ks = jax.random.split(key, 26)
    f32 = jnp.float32
    L, D, E, F = DEPTH, D_MODEL, N_EXPERTS, D_FF
    nrm = lambda k, shape, s: jax.random.normal(k, shape, f32) * s
    return {
        "x": nrm(ks[0], (BATCH, SEQ, D), 1.0),
        "c": nrm(ks[1], (BATCH, D), 1.0),
        "positions": jnp.broadcast_to(jnp.arange(SEQ, dtype=jnp.int32), (BATCH, SEQ)),
        "w_ada": nrm(ks[2], (L, D, 6 * D), 0.5 * D ** -0.5),
        "b_ada": nrm(ks[3], (L, 6 * D), 0.01),
        "w_in": nrm(ks[4], (L, D, IN_WIDTH), D ** -0.5),
        "gmlp_ln_g": 1.0 + nrm(ks[5], (L, GMLP_WIDTH), 0.01),
        "gmlp_ln_b": nrm(ks[6], (L, GMLP_WIDTH), 0.01),
        "w_spatial": nrm(ks[7], (L, GMLP_GROUPS, GMLP_CHUNK, GMLP_CHUNK), GMLP_CHUNK ** -0.5),
        "b_spatial": 1.0 + nrm(ks[8], (L, GMLP_GROUPS, GMLP_CHUNK), 0.01),
        "conv_w": nrm(ks[9], (L, CONV_K, CONV_WIDTH), CONV_K ** -0.5),
        "w_branch": nrm(ks[10], (L, N_BRANCH, BRANCH_WIDTH, D), DEEPNORM_BETA * BRANCH_WIDTH ** -0.5),
        "w_gate_up": nrm(ks[11], (L, N_BRANCH, GATE_RANK, D), GATE_RANK ** -0.5),
        "b_gate": nrm(ks[12], (L, N_BRANCH, D), 0.01),
        "w_out": nrm(ks[13], (L, D, D), DEEPNORM_BETA * D ** -0.5),
        "ln1_g": 1.0 + nrm(ks[14], (L, D), 0.01),
        "ln1_b": nrm(ks[15], (L, D), 0.01),
        "w_router": nrm(ks[16], (L, D, E), D ** -0.5),
        "b_router": nrm(ks[17], (L, E), 0.01),
        "w_gu": nrm(ks[18], (L, E, D, 2 * F), D ** -0.5),
        "b_gu": nrm(ks[19], (L, E, 2 * F), 0.01),
        "w_down": nrm(ks[20], (L, E, F, D), DEEPNORM_BETA * F ** -0.5),
        "b_down": nrm(ks[21], (L, E, D), 0.01),
        "ln2_g": 1.0 + nrm(ks[22], (L, D), 0.01),
        "ln2_b": nrm(ks[23], (L, D), 0.01),
    }


def reference(x, c, positions, w_ada, b_ada, w_in, gmlp_ln_g, gmlp_ln_b, w_spatial, b_spatial,
              conv_w, w_branch, w_gate_up, b_gate, w_out, ln1_g, ln1_b, w_router, b_router,
              w_gu, b_gu, w_down, b_down, ln2_g, ln2_b):
    out_dtype = x.dtype
    c_act = jax.nn.silu(c)
    for l in range(DEPTH):
        ada = c_act @ w_ada[l] + b_ada[l]
        sh1, sc1, gt1, sh2, sc2, gt2 = [a[:, None, :] for a in jnp.split(ada, 6, axis=-1)]
        h = x * (1.0 + sc1) + sh1
        mix = _hybrid_mixer(h, positions, w_in[l], gmlp_ln_g[l], gmlp_ln_b[l], w_spatial[l],
                            b_spatial[l], conv_w[l], w_branch[l], w_gate_up[l], b_gate[l], w_out[l])
        x = _layernorm(DEEPNORM_ALPHA * x + (1.0 + gt1) * mix, ln1_g[l], ln1_b[l])
        h2 = x * (1.0 + sc2) + sh2
        ffn = _moe(h2, w_router[l], b_router[l], w_gu[l], b_gu[l], w_down[l], b_down[l])
        x = _layernorm(DEEPNORM_ALPHA * x + (1.0 + gt2) * ffn, ln2_g[l], ln2_b[l])
    return x.astype(out_dtype)
```

```cpp
#include <hip/hip_runtime.h>
#include <cstdio>
#include <cstdint>

#ifndef MK_N_LAUNCHES
#define MK_N_LAUNCHES 1
#endif

#define LAS __attribute__((address_space(3)))
typedef unsigned short bf16_t;
typedef short bf16x8 __attribute__((ext_vector_type(8)));
typedef float f32x4 __attribute__((ext_vector_type(4)));
typedef float f32x2 __attribute__((ext_vector_type(2)));
typedef unsigned u32x4 __attribute__((ext_vector_type(4)));
typedef unsigned u32x2 __attribute__((ext_vector_type(2)));

constexpr int D = 1024, NB = 32, SEQ = 2048, T = NB * SEQ, NL = 4;
constexpr int INW = 2432, INWP = 2560;
constexpr int NE = 32, DFF = 256, NASG = T * 4;
constexpr int CH = 128, NCH = SEQ / CH;
constexpr float DN_ALPHA = 1.681792830507429f, LN_EPS = 1e-5f;
constexpr int PC_RQ = 0, PC_RK = 128, PC_RV = 256, PC_RG = 512, PC_GU = 768, PC_GV = 1024, PC_CB = 1280, PC_CC = 1536, PC_CX = 1792, PC_GC = 2048;

constexpr size_t WS_CTRL = 0, CTRL_BYTES = 65536;
constexpr size_t CTRL_CNT = 16384;
constexpr size_t WS_ADA = WS_CTRL + CTRL_BYTES;
constexpr size_t WS_KV = WS_ADA + (size_t)NL * NB * 6 * D * 4;
constexpr size_t WS_TOPI = WS_KV + (size_t)NB * NCH * 4 * 64 * 32 * 4;
constexpr size_t WS_TOKL = WS_TOPI + (size_t)T * 4 * 4;
constexpr size_t WS_WL = WS_TOKL + (size_t)NE * 65536 * 4;
constexpr size_t WS_WB = WS_WL + (size_t)NE * 65536 * 4;
constexpr size_t WB_WIN = 0;
constexpr size_t WB_WBR = WB_WIN + (size_t)INWP * D * 2;
constexpr size_t WB_WGT = WB_WBR + (size_t)3 * D * 256 * 2;
constexpr size_t WB_WOUT = WB_WGT + (size_t)3 * D * 128 * 2;
constexpr size_t WB_WGU = WB_WOUT + (size_t)D * D * 2;
constexpr size_t WB_WDN = WB_WGU + (size_t)NE * 512 * D * 2;
constexpr size_t WB_WRT = WB_WDN + (size_t)NE * D * 256 * 2;
constexpr size_t WB_WSP = WB_WRT + (size_t)NE * D * 2;
constexpr size_t WB_WRTL = WB_WSP + (size_t)4 * 128 * 128 * 2;
constexpr size_t WB_END = WB_WRTL + (size_t)NE * D * 2;
constexpr size_t WS_H = WS_WB + WB_END;
constexpr size_t WS_R = WS_H + (size_t)T * D * 2;
constexpr size_t R_P = 0;
constexpr size_t R_BR = R_P + (size_t)T * INWP * 2;
constexpr size_t R_MG = R_BR + (size_t)T * 768 * 2;
constexpr size_t R_END = R_MG + (size_t)T * D * 2;
constexpr size_t R_MIX = 0;
constexpr size_t R_HLO = (size_t)T * D * 2;
constexpr size_t R_OUT = 0;
static_assert((size_t)(NASG + 256) * D * 2 <= R_END, "OUT overlay (+256 dummy rows for masked stores)");
constexpr size_t WS_ACT = WS_R + R_END;
constexpr size_t WS_X16 = WS_ACT + (size_t)(NASG + 256) * DFF * 2;
constexpr size_t WS_END = WS_X16 + (size_t)T * D * 2;

constexpr int ST_BYTES = 49152;
constexpr int LDS_MAIN = 3 * ST_BYTES;
constexpr int LDS_TB = LDS_MAIN;
constexpr int LDS_IDS = LDS_TB + 1024;
constexpr int LDS_PRM = LDS_TB + 4096;
constexpr int LDS_XB = LDS_TB + 8192;
constexpr int LDS_BYTES = LDS_XB + 64;

#define XB_TMO      128
#define XB_XCNT(j)  (256  + 64 * (j))
#define XB_XSUB(j)  (1280 + 64 * (j))
#define XB_XGEN(j)  (2304 + 64 * (j))
#define XB_TOP      3328
#define XB_TOPGEN   3392
#define XCD_BAR_WORDS 3456
#define XB_SPIN_CAP (1u << 18)

__device__ __forceinline__ unsigned xb_ld(unsigned* p)              { return __hip_atomic_load(p, __ATOMIC_RELAXED, __HIP_MEMORY_SCOPE_AGENT); }
__device__ __forceinline__ unsigned xb_add(unsigned* p, unsigned v) { return __hip_atomic_fetch_add(p, v, __ATOMIC_RELAXED, __HIP_MEMORY_SCOPE_AGENT); }
__device__ __forceinline__ unsigned xb_xcc_id() { return (unsigned)__builtin_amdgcn_s_getreg((3 << 11) | 20) & 0xFu; }
#define XB_SPIN(cond, bar) do { unsigned _sp = 0; while (cond) { __builtin_amdgcn_s_sleep(1); \
    if ((++_sp & 255u) == 0u) { if (xb_ld(&(bar)[XB_TMO])) break; if (_sp > XB_SPIN_CAP) { atomicAdd(&(bar)[XB_TMO], 1u); break; } } } } while (0)

struct XcdBarrier { unsigned* bar; unsigned x; volatile LAS unsigned* st; };

__device__ __forceinline__ XcdBarrier xcd_barrier_post(unsigned* bar, volatile LAS unsigned* st, bool leader) {
    XcdBarrier b; b.bar = bar; b.x = xb_xcc_id(); b.st = st;
    if (leader) (void)xb_add(&bar[XB_XCNT(b.x)], 1u);
    return b;
}
__device__ __forceinline__ void xcd_barrier_complete(unsigned* bar, unsigned x, unsigned& nloc, unsigned& nx) {
    const unsigned G = gridDim.x * gridDim.y * gridDim.z;
    unsigned sum, cnt, mine, sp = 0u;
    for (;;) {
        sum = 0u; cnt = 0u; mine = 0u;
#pragma unroll
        for (unsigned j = 0; j < 16; ++j) { const unsigned c = xb_ld(&bar[XB_XCNT(j)]); sum += c; cnt += (c > 0u) ? 1u : 0u; mine = (j == x) ? c : mine; }
        if (sum == G) break;
        __builtin_amdgcn_s_sleep(1);
        if ((++sp & 255u) == 0u) { if (xb_ld(&bar[XB_TMO])) break; if (sp > XB_SPIN_CAP) { atomicAdd(&bar[XB_TMO], 1u); break; } }
    }
    nloc = mine > 0u ? mine : 1u; nx = cnt > 0u ? cnt : 1u;
}
__device__ __forceinline__ void xcd_barrier(const XcdBarrier& b, bool leader) {
    asm volatile("s_waitcnt vmcnt(0)" ::: "memory");
    __syncthreads();
    if (leader) {
        unsigned* bar = b.bar;
        __builtin_amdgcn_s_waitcnt(0);
        unsigned nloc = b.st[0], nx = b.st[1];
        if (nloc == 0u) { xcd_barrier_complete(bar, b.x, nloc, nx); b.st[0] = nloc; b.st[1] = nx; }
        const unsigned old = xb_add(&bar[XB_XSUB(b.x)], 1u);
        const unsigned gen = old / nloc;
        if (old + 1u == (gen + 1u) * nloc) {
            __builtin_amdgcn_fence(__ATOMIC_RELEASE, "agent");
            asm volatile("s_waitcnt vmcnt(0)" ::: "memory");
            const unsigned og = xb_add(&bar[XB_TOP], 1u);
            const unsigned tg = og / nx;
            if (og + 1u == (tg + 1u) * nx) xb_add(&bar[XB_TOPGEN], 1u);
            else XB_SPIN(xb_ld(&bar[XB_TOPGEN]) == tg, bar);
            __builtin_amdgcn_fence(__ATOMIC_ACQUIRE, "agent");
            xb_add(&bar[XB_XGEN(b.x)], 1u);
            asm volatile("s_waitcnt vmcnt(0)" ::: "memory");
        } else {
            XB_SPIN(xb_ld(&bar[XB_XGEN(b.x)]) == gen, bar);
            __builtin_amdgcn_fence(__ATOMIC_ACQUIRE, "agent");
            asm volatile("s_waitcnt vmcnt(0)" ::: "memory");
        }
    }
    __syncthreads();
}

typedef _Float16 h16x2 __attribute__((ext_vector_type(2)));
typedef _Float16 f16x8 __attribute__((ext_vector_type(8)));
__device__ __forceinline__ unsigned cvt_pk_bf16(float lo, float hi) { h16x2 v; v.x = (_Float16)lo; v.y = (_Float16)hi; return __builtin_bit_cast(unsigned, v); }
__device__ __forceinline__ float bf_lo(unsigned w) { return (float)__builtin_bit_cast(h16x2, w).x; }
__device__ __forceinline__ float bf_hi(unsigned w) { return (float)__builtin_bit_cast(h16x2, w).y; }
__device__ __forceinline__ float fsigmoid(float x) { return __builtin_amdgcn_rcpf(1.0f + __expf(-x)); }
__device__ __forceinline__ f32x4 sigmoid4(f32x4 x) {
    f32x4 e;
#pragma unroll
    for (int j = 0; j < 4; ++j) e[j] = 1.0f + __builtin_amdgcn_exp2f(fminf(fmaxf(x[j], -15.0f), 15.0f) * -1.4426950408889634f);
    const float ab = e[0] * e[1], cd = e[2] * e[3], r = __builtin_amdgcn_rcpf(ab * cd);
    const float rab = r * cd, rcd = r * ab;
    return (f32x4){rab * e[1], rab * e[0], rcd * e[3], rcd * e[2]};
}
__device__ __forceinline__ f32x4 sigmoid4_pre(f32x4 xs) {
    f32x4 e;
#pragma unroll
    for (int j = 0; j < 4; ++j) e[j] = 1.0f + __builtin_amdgcn_exp2f(__builtin_amdgcn_fmed3f(xs[j], -21.640425613334451f, 21.640425613334451f));
    const float ab = e[0] * e[1], cd = e[2] * e[3], r = __builtin_amdgcn_rcpf(ab * cd);
    const float rab = r * cd, rcd = r * ab;
    return (f32x4){rab * e[1], rab * e[0], rcd * e[3], rcd * e[2]};
}
typedef _Float16 h2_t __attribute__((ext_vector_type(2)));
__device__ __forceinline__ unsigned pk_fma_h2(unsigned a, unsigned b, unsigned c) { return __builtin_bit_cast(unsigned, __builtin_elementwise_fma(__builtin_bit_cast(h2_t, a), __builtin_bit_cast(h2_t, b), __builtin_bit_cast(h2_t, c))); }
__device__ __forceinline__ float gelu_tanh(float x) { const float u = 0.7978845608028654f * (x + 0.044715f * x * x * x); return x * fsigmoid(2.0f * u); }
#define DPP_ADD(v, ctrl, rm) (v) += __builtin_bit_cast(float, __builtin_amdgcn_update_dpp(0, __builtin_bit_cast(int, (v)), (ctrl), (rm), 0xf, false))
__device__ __forceinline__ float wave_sum(float v) {
    DPP_ADD(v, 0xB1, 0xf);
    DPP_ADD(v, 0x4E, 0xf);
    DPP_ADD(v, 0x141, 0xf);
    DPP_ADD(v, 0x140, 0xf);
    DPP_ADD(v, 0x142, 0xa);
    DPP_ADD(v, 0x143, 0xc);
    return __builtin_bit_cast(float, __builtin_amdgcn_readlane(__builtin_bit_cast(int, v), 63));
}
__device__ __forceinline__ int opaque_tid(int wid) { int l; asm volatile("v_mbcnt_lo_u32_b32 %0, -1, 0\n\tv_mbcnt_hi_u32_b32 %0, -1, %0" : "=v"(l)); return (wid << 6) | l; }
__device__ __forceinline__ const char* uni_ptr(const char* p) { const unsigned long long v = (unsigned long long)p; const unsigned lo = __builtin_amdgcn_readfirstlane((unsigned)v), hi = __builtin_amdgcn_readfirstlane((unsigned)(v >> 32)); return (const char*)(((unsigned long long)hi << 32) | lo); }
#define UNI(x) __builtin_amdgcn_readfirstlane(x)
#define GLDS16(gp, lp) __builtin_amdgcn_global_load_lds((const unsigned*)(gp), (LAS unsigned*)(lp), 16, 0, 0)
#define WAIT_V(n) asm volatile("s_waitcnt vmcnt(" #n ")" ::: "memory")
#define WAIT_L0() asm volatile("s_waitcnt lgkmcnt(0)" ::: "memory")
#define SBAR() __builtin_amdgcn_s_barrier()
#define MFMA16(a, b, c) __builtin_amdgcn_mfma_f32_16x16x32_f16(__builtin_bit_cast(f16x8, (a)), __builtin_bit_cast(f16x8, (b)), (c), 0, 0, 0)

__device__ __forceinline__ int lds_byte(int r, int c) { return r * 128 + ((((c >> 3) ^ (r >> 1)) & 7) << 4) + (c & 7) * 2; }
__device__ __forceinline__ void stage_rc(int b, int& R, int& C) { R = b >> 7; C = ((((b >> 4) ^ (R >> 1)) & 7)) * 8; }
__device__ __forceinline__ int perm32(int rho) { const int n = rho >> 4, i = rho & 15; return 8 * (i >> 2) + 4 * n + (i & 3); }

struct Args { const void* in[25]; float* out; unsigned char* ws; int ph_lo, ph_hi; };
typedef const __attribute__((address_space(4))) Args* KArgsPtr;
struct Ctx {
    KArgsPtr ka; float* out; unsigned char* ws;
    LAS unsigned char* lds;
    int tid, lane, wid, G, bx;
    __device__ __forceinline__ const float* x() const { return (const float*)ka->in[0]; }
    __device__ __forceinline__ const float* c() const { return (const float*)ka->in[1]; }
    __device__ __forceinline__ const int* pos() const { return (const int*)ka->in[2]; }
    __device__ __forceinline__ const float* w_ada() const { return (const float*)ka->in[3]; }
    __device__ __forceinline__ const float* b_ada() const { return (const float*)ka->in[4]; }
    __device__ __forceinline__ const float* w_in() const { return (const float*)ka->in[5]; }
    __device__ __forceinline__ const float* gln_g() const { return (const float*)ka->in[6]; }
    __device__ __forceinline__ const float* gln_b() const { return (const float*)ka->in[7]; }
    __device__ __forceinline__ const float* w_sp() const { return (const float*)ka->in[8]; }
    __device__ __forceinline__ const float* b_sp() const { return (const float*)ka->in[9]; }
    __device__ __forceinline__ const float* conv_w() const { return (const float*)ka->in[10]; }
    __device__ __forceinline__ const float* w_br() const { return (const float*)ka->in[11]; }
    __device__ __forceinline__ const float* w_gt() const { return (const float*)ka->in[12]; }
    __device__ __forceinline__ const float* b_gt() const { return (const float*)ka->in[13]; }
    __device__ __forceinline__ const float* w_out() const { return (const float*)ka->in[14]; }
    __device__ __forceinline__ const float* ln1_g() const { return (const float*)ka->in[15]; }
    __device__ __forceinline__ const float* ln1_b() const { return (const float*)ka->in[16]; }
    __device__ __forceinline__ const float* w_rt() const { return (const float*)ka->in[17]; }
    __device__ __forceinline__ const float* b_rt() const { return (const float*)ka->in[18]; }
    __device__ __forceinline__ const float* w_gu() const { return (const float*)ka->in[19]; }
    __device__ __forceinline__ const float* b_gu() const { return (const float*)ka->in[20]; }
    __device__ __forceinline__ const float* w_dn() const { return (const float*)ka->in[21]; }
    __device__ __forceinline__ const float* b_dn() const { return (const float*)ka->in[22]; }
    __device__ __forceinline__ const float* ln2_g() const { return (const float*)ka->in[23]; }
    __device__ __forceinline__ const float* ln2_b() const { return (const float*)ka->in[24]; }
};

__device__ __forceinline__ bool sched_unit(const Ctx& X, int r, int NU, int& u) {
    const int L = r * X.G + X.bx;
    if ((X.G & 7) == 0) { const int x = L & 7, off = L >> 3, q = (NU + 7) >> 3; u = x * q + off; return off < q && u < NU; }
    u = L; return u < NU;
}

struct GUnit { const char* a; const char* a1; const char* b; unsigned va[2][2]; int r0, c0, e, valid, xi; };

template <class Prob>
__device__ __forceinline__ void gemm_run(const Ctx& X, Prob& pr) {
    LAS unsigned char* lds = X.lds;
    const int wid = X.wid, lane = X.lane;
    const int wr = wid >> 2, wc = wid & 3, fr = lane & 15, fq = lane >> 4;
    const int aoff = lds_byte(wr * 64 + fr, fq * 8), boff = lds_byte(wc * 32 + fr, fq * 8), aoff1 = aoff ^ 64, boff1 = boff ^ 64;
    const unsigned ldsw = (unsigned)wid * 1024u;
    const int NU = pr.nunits();
    int u;
    if (!sched_unit(X, 0, NU, u)) return;
    GUnit cur, nxt;
    pr.decode(u, cur); nxt = cur;
    f32x4 acc[2][4][2];
#pragma unroll
    for (int a = 0; a < 2; ++a)
#pragma unroll
        for (int m = 0; m < 4; ++m)
#pragma unroll
            for (int n = 0; n < 2; ++n) acc[a][m][n] = (f32x4){0.f, 0.f, 0.f, 0.f};
    pr.issue(lds, 0u, ldsw, cur, 0);
    pr.issue(lds, (unsigned)ST_BYTES, ldsw, cur, 1);
    int ui = 0; unsigned so = 0;
    for (;;) {
        int un; const bool has_next = sched_unit(X, ui + 1, NU, un);
        if (has_next) pr.decode(un, nxt);
#pragma nounroll
        for (int kt = 0; kt < Prob::NK; ++kt) {
            const bool more = (kt + 1 < Prob::NK) || has_next;
            if (more) WAIT_V(6); else WAIT_V(0);
            SBAR();
            if (kt == 0) pr.params_issue(ui & 1, cur);
            unsigned s2 = so + 2u * ST_BYTES; if (s2 >= 3u * ST_BYTES) s2 -= 3u * ST_BYTES;
            if (kt + 2 < Prob::NK) pr.issue(lds, s2, ldsw, cur, kt + 2);
            else if (has_next) pr.issue(lds, s2, ldsw, nxt, kt + 2 - Prob::NK);
            bf16x8 Bf[2][2], Aq0[2][2], Aq1[2][2];
#define GS_LDAQ(dst, q) do { _Pragma("unroll") for (int m = 0; m < 2; ++m) _Pragma("unroll") for (int k = 0; k < 2; ++k) dst[m][k] = *(const LAS bf16x8*)(lds + so + ((q) >> 1) * 16384 + (k ? aoff1 : aoff) + (2 * ((q) & 1) + m) * 2048); } while (0)
#define GS_MMAQ(src_, q) do { __builtin_amdgcn_s_setprio(1); _Pragma("unroll") for (int m = 0; m < 2; ++m) _Pragma("unroll") for (int n = 0; n < 2; ++n) _Pragma("unroll") for (int k = 0; k < 2; ++k) \
                acc[(q) >> 1][2 * ((q) & 1) + m][n] = MFMA16(Bf[n][k], src_[m][k], acc[(q) >> 1][2 * ((q) & 1) + m][n]); __builtin_amdgcn_s_setprio(0); } while (0)
#pragma unroll
            for (int n = 0; n < 2; ++n)
#pragma unroll
                for (int k = 0; k < 2; ++k) Bf[n][k] = *(const LAS bf16x8*)(lds + so + 32768 + (k ? boff1 : boff) + n * 2048);
            GS_LDAQ(Aq0, 0); __builtin_amdgcn_sched_barrier(0);
            GS_LDAQ(Aq1, 1); __builtin_amdgcn_sched_barrier(0);
            GS_MMAQ(Aq0, 0); __builtin_amdgcn_sched_barrier(0);
            GS_LDAQ(Aq0, 2); __builtin_amdgcn_sched_barrier(0);
            GS_MMAQ(Aq1, 1); __builtin_amdgcn_sched_barrier(0);
            GS_LDAQ(Aq1, 3); __builtin_amdgcn_sched_barrier(0);
            GS_MMAQ(Aq0, 2); __builtin_amdgcn_sched_barrier(0);
            GS_MMAQ(Aq1, 3); __builtin_amdgcn_sched_barrier(0);
#undef GS_LDAQ
#undef GS_MMAQ
            pr.after_step(acc, cur, kt, ui & 1);
            so += ST_BYTES; if (so >= 3u * ST_BYTES) so = 0;
        }
        if (!has_next) break;
        cur = nxt; ++ui;
    }
    WAIT_L0(); SBAR();
}

__device__ __forceinline__ void zero_acc4(f32x4 (&acc)[2][2][4]) {
#pragma unroll
    for (int a = 0; a < 2; ++a)
#pragma unroll
        for (int m = 0; m < 2; ++m)
#pragma unroll
            for (int n = 0; n < 4; ++n) acc[a][m][n] = (f32x4){0.f, 0.f, 0.f, 0.f};
}
__device__ __forceinline__ void zero_acc(f32x4 (&acc)[2][4][2]) {
#pragma unroll
    for (int a = 0; a < 2; ++a)
#pragma unroll
        for (int m = 0; m < 4; ++m)
#pragma unroll
            for (int n = 0; n < 2; ++n) acc[a][m][n] = (f32x4){0.f, 0.f, 0.f, 0.f};
}

template <class Prob>
__device__ __forceinline__ void merge_run(const Ctx& X, Prob& pr) {
    LAS unsigned char* lds = X.lds;
    const int wid = X.wid, lane = X.lane;
    const int wr4 = wid >> 1, wc2 = wid & 1, fr = lane & 15, fq = lane >> 4;
    const int aoff = lds_byte(wr4 * 32 + fr, fq * 8), boff = lds_byte(wc2 * 64 + fr, fq * 8), aoff1 = aoff ^ 64, boff1 = boff ^ 64;
    const unsigned ldsw = (unsigned)wid * 1024u;
    const int NU = pr.nunits();
    int u;
    if (!sched_unit(X, 0, NU, u)) return;
    GUnit cur, nxt;
    pr.decode(u, cur); nxt = cur;
    f32x4 acc[2][2][4];
    zero_acc4(acc);
    pr.issue(lds, 0u, ldsw, cur, 0);
    pr.issue(lds, (unsigned)ST_BYTES, ldsw, cur, 1);
    int ui = 0; unsigned so = 0;
    int pi = 0, pr0 = cur.r0, pc0 = cur.c0;
    for (;;) {
        int un; const bool has_next = sched_unit(X, ui + 1, NU, un);
        if (has_next) pr.decode(un, nxt);
#pragma nounroll
        for (int i = 0; i < 3; ++i) {
#pragma unroll
            for (int j = 0; j < 6; ++j) {
                const int kt = 6 * i + j;
                const bool more = (kt + 1 < Prob::NK) || has_next;
                if (more) WAIT_V(6); else WAIT_V(0);
                SBAR();
                if (j == 0 && i == 0) pr.params_issue(ui & 1, cur);
                unsigned s2 = so + 2u * ST_BYTES; if (s2 >= 3u * ST_BYTES) s2 -= 3u * ST_BYTES;
                if (kt + 2 < Prob::NK) pr.issue(lds, s2, ldsw, cur, kt + 2);
                else if (has_next) pr.issue(lds, s2, ldsw, nxt, kt + 2 - Prob::NK);
                bf16x8 Bf[4][2], Aq0[2], Aq1[2];
#define GS_LDAQ(dst, q) do { _Pragma("unroll") for (int k = 0; k < 2; ++k) dst[k] = *(const LAS bf16x8*)(lds + so + ((q) >> 1) * 16384 + (k ? aoff1 : aoff) + ((q) & 1) * 2048); } while (0)
#define GS_MMAQ(src_, q) do { __builtin_amdgcn_s_setprio(1); _Pragma("unroll") for (int n = 0; n < 4; ++n) _Pragma("unroll") for (int k = 0; k < 2; ++k) \
                acc[(q) >> 1][(q) & 1][n] = MFMA16(Bf[n][k], src_[k], acc[(q) >> 1][(q) & 1][n]); __builtin_amdgcn_s_setprio(0); } while (0)
#pragma unroll
                for (int n = 0; n < 4; ++n)
#pragma unroll
                    for (int k = 0; k < 2; ++k) Bf[n][k] = *(const LAS bf16x8*)(lds + so + 32768 + (k ? boff1 : boff) + n * 2048);
                GS_LDAQ(Aq0, 0); __builtin_amdgcn_sched_barrier(0);
                GS_LDAQ(Aq1, 1); __builtin_amdgcn_sched_barrier(0);
                GS_MMAQ(Aq0, 0); __builtin_amdgcn_sched_barrier(0);
                GS_LDAQ(Aq0, 2); __builtin_amdgcn_sched_barrier(0);
                GS_MMAQ(Aq1, 1); __builtin_amdgcn_sched_barrier(0);
                GS_LDAQ(Aq1, 3); __builtin_amdgcn_sched_barrier(0);
                GS_MMAQ(Aq0, 2); __builtin_amdgcn_sched_barrier(0);
                GS_MMAQ(Aq1, 3); __builtin_amdgcn_sched_barrier(0);
#undef GS_LDAQ
#undef GS_MMAQ
                if (j == 0) pr.template chunk<0>(pi, pr0, pc0); else if (j == 1) pr.template chunk<1>(pi, pr0, pc0); else if (j == 2) pr.template chunk<2>(pi, pr0, pc0); else if (j == 3) pr.template chunk<3>(pi, pr0, pc0);
                __builtin_amdgcn_sched_barrier(0);
                if (j == 3) pr.park_y(acc);
                if (j == 5) { pr.park_h(acc, i, ui & 1); pi = i; pr0 = cur.r0; pc0 = cur.c0; }
                so += ST_BYTES; if (so >= 3u * ST_BYTES) so = 0;
            }
        }
        if (!has_next) break;
        cur = nxt; ++ui;
    }
    pr.template chunk<0>(pi, pr0, pc0); pr.template chunk<1>(pi, pr0, pc0); pr.template chunk<2>(pi, pr0, pc0); pr.template chunk<3>(pi, pr0, pc0);
    WAIT_L0(); SBAR();
}

struct LaneGeo { int wr, wc, fr, fq; int R[2], C[2], Rb[2]; };
__device__ __forceinline__ LaneGeo lane_geo(const Ctx& X) {
    LaneGeo g; g.wr = X.wid >> 2; g.wc = X.wid & 3; g.fr = X.lane & 15; g.fq = X.lane >> 4;
#pragma unroll
    for (int i = 0; i < 2; ++i) { int R, C; stage_rc(X.tid * 16 + i * 8192, R, C); g.R[i] = R; g.C[i] = C; g.Rb[i] = (R & ~31) + perm32(R & 31); }
    return g;
}
__device__ __forceinline__ void issue_std(LAS unsigned char* lds, unsigned so, unsigned ldsw, const char* a0, const char* a1, const unsigned (&va0)[2], const unsigned (&va1)[2], const char* b, const unsigned (&vb)[2]) {
    a0 = uni_ptr(a0); a1 = uni_ptr(a1); b = uni_ptr(b);
#pragma unroll
    for (int i = 0; i < 2; ++i) GLDS16(a0 + va0[i], lds + so + ldsw + i * 8192);
#pragma unroll
    for (int i = 0; i < 2; ++i) GLDS16(a1 + va1[i], lds + so + 16384 + ldsw + i * 8192);
#pragma unroll
    for (int i = 0; i < 2; ++i) GLDS16(b + vb[i], lds + so + 32768 + ldsw + i * 8192);
}
__device__ __forceinline__ void refresh(Ctx& X) { KArgsPtr k = X.ka; asm volatile("" : "+s"(k)); X.ka = k; const int t = opaque_tid(X.wid); X.tid = t; X.lane = t & 63; }

__device__ __forceinline__ void moe_tables(const Ctx& X, int layer) {
    LAS int* tb = (LAS int*)(X.lds + LDS_TB);
    if (X.tid < 32) {
        const unsigned* cnt = (const unsigned*)(X.ws + WS_CTRL + CTRL_CNT) + layer * 32;
        const int e = X.tid, c = (int)__hip_atomic_load(cnt + e, __ATOMIC_RELAXED, __HIP_MEMORY_SCOPE_AGENT), tl = (c + 255) >> 8;
        int so = c, st = tl;
#pragma unroll
        for (int o = 1; o < 32; o <<= 1) { const int a = __shfl_up(so, o, 32), b2 = __shfl_up(st, o, 32); if (e >= o) { so += a; st += b2; } }
        tb[e] = c; tb[32 + e] = so - c; tb[65 + e] = st - tl;
        if (e == 31) { tb[64] = so; tb[97] = st; }
    }
    __syncthreads();
}
__device__ __forceinline__ void moe_find(const LAS int* tb, int tile, int& e, int& j) {
    int l; asm volatile("v_mbcnt_lo_u32_b32 %0, -1, 0" : "=v"(l));
    const unsigned long long m = __ballot(tb[65 + l] <= tile);
    const int ee = __builtin_popcount((unsigned)m) - 1;
    e = ee; j = tile - tb[65 + ee];
}

struct G8Unit { const char* a0; const char* a1; const char* b0; const char* b1; int r0, c0, e, valid, xi; };
constexpr int HTB = 16384;

template <class Prob, bool SP2 = false>
__device__ __forceinline__ void gemm8_run(const Ctx& X, Prob& pr) {
    LAS unsigned char* lds = X.lds;
    const int wid = X.wid, lane = X.lane, wr = wid >> 2, wc = wid & 3, fr = lane & 15, fq = lane >> 4;
    constexpr int nt = Prob::NK;
    const int aoff = lds_byte(wr * 64 + fr, fq * 8), boff = lds_byte(wc * 32 + fr, fq * 8), aoff1 = aoff ^ 64, boff1 = boff ^ 64;
    const unsigned ldsw = (unsigned)wid * 1024u;
    const int NU = pr.nunits();
    int u;
    if (!sched_unit(X, 0, NU, u)) return;
    G8Unit cur, nxt;
    pr.decode(u, cur); nxt = cur;
    unsigned vaC[2][2], vaN[2][2];
    pr.first_va(cur, vaC);
#pragma unroll
    for (int h = 0; h < 2; ++h)
#pragma unroll
        for (int i = 0; i < 2; ++i) vaN[h][i] = vaC[h][i];
    const unsigned vb0 = pr.vb[0], vb1 = pr.vb[1];
    f32x4 acc[2][2][4][2];
#pragma unroll
    for (int a = 0; a < 2; ++a)
#pragma unroll
        for (int b = 0; b < 2; ++b)
#pragma unroll
            for (int m = 0; m < 4; ++m)
#pragma unroll
                for (int n = 0; n < 2; ++n) acc[a][b][m][n] = (f32x4){0.f, 0.f, 0.f, 0.f};
    bf16x8 At[4][2], B0[2][2], B1[2][2];
    constexpr unsigned kstep = 128u;
#define G8_SA(b, h) (((b) * 2 + (h)) * HTB)
#define G8_SB(b, h) ((4 + (b) * 2 + (h)) * HTB)
#define G8_STAGE(bufoff, gbase, v0, v1) do { const char* _sb = uni_ptr(gbase); GLDS16(_sb + (v0), lds + (bufoff) + ldsw); GLDS16(_sb + (v1), lds + (bufoff) + ldsw + 8192); } while (0)
#define G8_LDA(dst, b, h) do { _Pragma("unroll") for (int m = 0; m < 4; ++m) _Pragma("unroll") for (int k = 0; k < 2; ++k) dst[m][k] = *(const LAS bf16x8*)(lds + G8_SA(b, h) + (k ? aoff1 : aoff) + m * 2048); } while (0)
#define G8_LDB(dst, b, h) do { _Pragma("unroll") for (int n = 0; n < 2; ++n) _Pragma("unroll") for (int k = 0; k < 2; ++k) dst[n][k] = *(const LAS bf16x8*)(lds + G8_SB(b, h) + (k ? boff1 : boff) + n * 2048); } while (0)
#define G8_MMA(ai, bj, At_, Bt_) do { __builtin_amdgcn_s_setprio(1); _Pragma("unroll") for (int m = 0; m < 4; ++m) _Pragma("unroll") for (int n = 0; n < 2; ++n) _Pragma("unroll") for (int k = 0; k < 2; ++k) \
        acc[ai][bj][m][n] = MFMA16(Bt_[n][k], At_[m][k], acc[ai][bj][m][n]); __builtin_amdgcn_s_setprio(0); } while (0)
#define G8_WAIT_L(n) asm volatile("s_waitcnt lgkmcnt(" #n ")" ::: "memory")
#define G8_SCHED __builtin_amdgcn_sched_barrier(0)
    const unsigned kr0 = Prob::KROT ? (unsigned)cur.xi * kstep : 0u;
    if constexpr (SP2) {
        G8_STAGE(G8_SB(0, 0), cur.b0 + kr0, vb0, vb1); G8_STAGE(G8_SB(0, 1), cur.b1 + kr0, vb0, vb1); G8_STAGE(G8_SA(0, 0), cur.a0 + kr0, vaC[0][0], vaC[0][1]); G8_STAGE(G8_SA(0, 1), cur.a1 + kr0, vaC[1][0], vaC[1][1]);
        if (wr == 1) SBAR();
        WAIT_V(2); SBAR();
    } else {
    G8_STAGE(G8_SB(0, 0), cur.b0 + kr0, vb0, vb1); G8_STAGE(G8_SA(0, 0), cur.a0 + kr0, vaC[0][0], vaC[0][1]); G8_STAGE(G8_SB(0, 1), cur.b1 + kr0, vb0, vb1); G8_STAGE(G8_SA(0, 1), cur.a1 + kr0, vaC[1][0], vaC[1][1]);
    if (wr == 1) SBAR();
    WAIT_V(4); SBAR();
    }
    G8_STAGE(G8_SB(1, 0), cur.b0 + kr0 + kstep, vb0, vb1); G8_STAGE(G8_SA(1, 0), cur.a0 + kr0 + kstep, vaC[0][0], vaC[0][1]); G8_STAGE(G8_SB(1, 1), cur.b1 + kr0 + kstep, vb0, vb1);
    WAIT_V(6); SBAR();
    int ui = 0;
    for (;;) {
        int un; const bool has_next = sched_unit(X, ui + 1, NU, un);
        if (has_next) pr.decode(un, nxt);
        const unsigned nkr = Prob::KROT ? (unsigned)(has_next ? nxt.xi : cur.xi) * kstep : 0u;
        const char* nA0 = (has_next ? nxt.a0 : cur.a0) + nkr; const char* nA1 = (has_next ? nxt.a1 : cur.a1) + nkr; const char* nB0 = (has_next ? nxt.b0 : cur.b0) + nkr; const char* nB1 = (has_next ? nxt.b1 : cur.b1) + nkr;
#pragma nounroll
        for (int t = 0; t < nt; t += 2) {
            const bool last = (t == nt - 2);
            if (t == 0) pr.params_issue(ui & 1, cur);
            if constexpr (Prob::GATHER) {
                if (t == 0 && has_next) pr.ids_issue((ui + 1) & 1, nxt);
                if (last && has_next) pr.ids_read((ui + 1) & 1, vaN);
            }
            unsigned j1 = (unsigned)t, j2 = (unsigned)t + 2u;
            if constexpr (Prob::KROT) { j1 = (j1 + (unsigned)cur.xi) & (unsigned)(nt - 1); j2 = (j2 + (unsigned)cur.xi) & (unsigned)(nt - 1); }
            const char* a1h1 = cur.a1 + (j1 + 1u) * kstep;
            const char* a2h0 = last ? nA0 : cur.a0 + j2 * kstep; const char* a2h1 = last ? nA1 : cur.a1 + j2 * kstep;
            const char* b2h0 = last ? nB0 : cur.b0 + j2 * kstep; const char* b2h1 = last ? nB1 : cur.b1 + j2 * kstep;
            unsigned v200 = vaC[0][0], v201 = vaC[0][1], v210 = vaC[1][0], v211 = vaC[1][1];
            if constexpr (Prob::GATHER) { if (last) { v200 = vaN[0][0]; v201 = vaN[0][1]; v210 = vaN[1][0]; v211 = vaN[1][1]; } }
            if constexpr (SP2) {
            G8_LDB(B0, 0, 0); G8_LDB(B1, 0, 1); G8_SCHED; G8_LDA(At, 0, 0); G8_STAGE(G8_SA(1, 1), a1h1, vaC[1][0], vaC[1][1]);
            WAIT_V(8); G8_WAIT_L(0); SBAR(); G8_MMA(0, 0, At, B0); G8_MMA(0, 1, At, B1); SBAR(); G8_SCHED;
            G8_LDA(At, 0, 1); G8_STAGE(G8_SB(0, 0), b2h0, vb0, vb1); G8_STAGE(G8_SB(0, 1), b2h1, vb0, vb1); G8_STAGE(G8_SA(0, 0), a2h0, v200, v201);
            WAIT_V(8); G8_WAIT_L(0); SBAR(); G8_MMA(1, 0, At, B0); G8_MMA(1, 1, At, B1); SBAR(); G8_SCHED;
            G8_LDB(B0, 1, 0); G8_LDB(B1, 1, 1); G8_SCHED; G8_LDA(At, 1, 0); G8_STAGE(G8_SA(0, 1), a2h1, v210, v211);
            WAIT_V(8); G8_WAIT_L(0); SBAR(); G8_MMA(0, 0, At, B0); G8_MMA(0, 1, At, B1); SBAR(); G8_SCHED;
            G8_LDA(At, 1, 1); G8_STAGE(G8_SB(1, 0), b2h0 + kstep, vb0, vb1); G8_STAGE(G8_SB(1, 1), b2h1 + kstep, vb0, vb1); G8_STAGE(G8_SA(1, 0), a2h0 + kstep, v200, v201);
            WAIT_V(8); G8_WAIT_L(0); SBAR(); G8_MMA(1, 0, At, B0); G8_MMA(1, 1, At, B1); SBAR(); G8_SCHED;
            } else {
            G8_LDB(B0, 0, 0); G8_SCHED; G8_LDA(At, 0, 0); G8_STAGE(G8_SA(1, 1), a1h1, vaC[1][0], vaC[1][1]);
            G8_WAIT_L(8); SBAR(); G8_WAIT_L(0); G8_MMA(0, 0, At, B0); SBAR(); G8_SCHED;
            G8_LDB(B1, 0, 1); G8_STAGE(G8_SB(0, 0), b2h0, vb0, vb1);
            SBAR(); G8_WAIT_L(0); G8_MMA(0, 1, At, B1); SBAR();
            G8_LDA(At, 0, 1); G8_STAGE(G8_SA(0, 0), a2h0, v200, v201);
            SBAR(); G8_WAIT_L(0); G8_MMA(1, 0, At, B0); SBAR(); G8_SCHED;
            G8_STAGE(G8_SB(0, 1), b2h1, vb0, vb1);
            WAIT_V(6); SBAR(); G8_MMA(1, 1, At, B1); SBAR();
            G8_LDB(B0, 1, 0); G8_SCHED; G8_LDA(At, 1, 0); G8_STAGE(G8_SA(0, 1), a2h1, v210, v211);
            G8_WAIT_L(8); SBAR(); G8_WAIT_L(0); G8_MMA(0, 0, At, B0); SBAR(); G8_SCHED;
            G8_LDB(B1, 1, 1); G8_STAGE(G8_SB(1, 0), b2h0 + kstep, vb0, vb1);
            SBAR(); G8_WAIT_L(0); G8_MMA(0, 1, At, B1); SBAR();
            G8_LDA(At, 1, 1); G8_STAGE(G8_SA(1, 0), a2h0 + kstep, v200, v201);
            SBAR(); G8_WAIT_L(0); G8_MMA(1, 0, At, B0); SBAR(); G8_SCHED;
            G8_STAGE(G8_SB(1, 1), b2h1 + kstep, vb0, vb1);
            WAIT_V(6); SBAR(); G8_MMA(1, 1, At, B1); SBAR();
            }
        }
        pr.epilogue(acc, cur, ui & 1);
        if (!has_next) break;
#pragma unroll
        for (int a = 0; a < 2; ++a)
#pragma unroll
            for (int b = 0; b < 2; ++b)
#pragma unroll
                for (int m = 0; m < 4; ++m)
#pragma unroll
                    for (int n = 0; n < 2; ++n) acc[a][b][m][n] = (f32x4){0.f, 0.f, 0.f, 0.f};
        cur = nxt; ++ui;
        if constexpr (Prob::GATHER) {
#pragma unroll
            for (int h = 0; h < 2; ++h)
#pragma unroll
                for (int i = 0; i < 2; ++i) vaC[h][i] = vaN[h][i];
        }
    }
    WAIT_V(0);
    if (wr == 0) SBAR();
    SBAR();
#undef G8_SA
#undef G8_SB
#undef G8_STAGE
#undef G8_LDA
#undef G8_LDB
#undef G8_MMA
#undef G8_WAIT_L
#undef G8_SCHED
}

__device__ __forceinline__ void store_tile8(const f32x4 (&acc)[2][2][4][2], bf16_t* O, int ldc, int r0, int c0, int wq, int nbj = 2) {
    const int t = opaque_tid(wq), wid = t >> 6, lane = t & 63, wr = wid >> 2, wc = wid & 3, fr = lane & 15, fq = lane >> 4;
#pragma unroll
    for (int ai = 0; ai < 2; ++ai)
#pragma unroll
        for (int m = 0; m < 4; ++m) {
            bf16_t* p = O + (size_t)(r0 + 128 * ai + 64 * wr + 16 * m + fr) * ldc + c0 + 32 * wc + 8 * fq;
#pragma unroll
            for (int bj = 0; bj < 2; ++bj) if (bj < nbj) { const f32x4 v0 = acc[ai][bj][m][0], v1 = acc[ai][bj][m][1];
                u32x4 w; w.x = cvt_pk_bf16(v0[0], v0[1]); w.y = cvt_pk_bf16(v0[2], v0[3]); w.z = cvt_pk_bf16(v1[0], v1[1]); w.w = cvt_pk_bf16(v1[2], v1[3]);
                *(u32x4*)(p + 128 * bj) = w; }
        }
}

template <int NK_> struct ProbDense8 {
    static constexpr int NK = NK_; static constexpr bool GATHER = false; static constexpr bool KROT = true;
    const char* A; const char* B; bf16_t* O; int K, ldc, ncol, nu; unsigned va0[2], vb[2]; int wq; int ncv;
    __device__ __forceinline__ void init(const Ctx& X, const void* A_, const void* B_, bf16_t* O_, int ldc_, int ncol_, int nrow_) {
        ncv = ldc_; wq = X.wid; A = (const char*)A_; B = (const char*)B_; O = O_; K = NK_ * 64; ldc = ldc_; ncol = ncol_; nu = ncol_ * nrow_; const LaneGeo lg = lane_geo(X);
#pragma unroll
        for (int i = 0; i < 2; ++i) { va0[i] = (unsigned)(lg.R[i] * K + lg.C[i]) * 2u; vb[i] = (unsigned)(lg.Rb[i] * K + lg.C[i]) * 2u; }
    }
    __device__ __forceinline__ int nunits() const { return nu; }
    __device__ __forceinline__ void decode(int u, G8Unit& g) const {
        const int gsz = 8 * ncol, gid = u / gsz, rr = u - gid * gsz, pm = gid * 8 + (rr & 7), pn = rr >> 3;
        g.a0 = uni_ptr(A + (size_t)pm * 256 * K * 2); g.a1 = g.a0 + (size_t)128 * K * 2; g.b0 = uni_ptr(B + (size_t)pn * 256 * K * 2); g.b1 = g.b0 + (size_t)128 * K * 2;
        g.r0 = pm * 256; g.c0 = pn * 256; g.e = 0; g.valid = 256; g.xi = 2 * (pm & (NK_ / 2 - 1));
    }
    __device__ __forceinline__ void first_va(const G8Unit&, unsigned (&va)[2][2]) const {
#pragma unroll
        for (int h = 0; h < 2; ++h)
#pragma unroll
            for (int i = 0; i < 2; ++i) va[h][i] = va0[i]; }
    __device__ __forceinline__ void params_issue(int, const G8Unit&) const {}
    __device__ __forceinline__ void epilogue(const f32x4 (&acc)[2][2][4][2], const G8Unit& g, int) const { store_tile8(acc, O, ldc, g.r0, g.c0, wq, (g.c0 + 128 < ncv) ? 2 : 1); }
};

struct ProbGU8 {
    static constexpr int NK = 16; static constexpr bool GATHER = true; static constexpr bool KROT = false;
    const char* H; const char* W; bf16_t* ACT; const int* toklist; const float* bgu; const LAS int* tb; LAS unsigned char* lds; unsigned vb[2]; int wq;
    __device__ __forceinline__ void init(const Ctx& X, int layer) {
        wq = X.wid;
        H = (const char*)(X.ws + WS_H); W = (const char*)(X.ws + WS_WB + WB_WGU); ACT = (bf16_t*)(X.ws + WS_ACT); toklist = (const int*)(X.ws + WS_TOKL);
        bgu = X.b_gu() + (size_t)layer * NE * 512; tb = (const LAS int*)(X.lds + LDS_TB); lds = X.lds; const LaneGeo lg = lane_geo(X);
#pragma unroll
        for (int i = 0; i < 2; ++i) vb[i] = (unsigned)(lg.Rb[i] * 1024 + lg.C[i]) * 2u;
    }
    __device__ __forceinline__ int nunits() const { return tb[97] * 2; }
    __device__ __forceinline__ void decode(int u, G8Unit& g) const {
        const int tile = u >> 1, pn = u & 1; int e, j; moe_find(tb, tile, e, j); e = UNI(e); j = UNI(j);
        const int cnt = UNI(tb[e]), base = 256 * j;
        g.a0 = uni_ptr(H); g.a1 = g.a0; g.b0 = uni_ptr(W + (size_t)(e * 512 + 256 * pn) * 1024 * 2); g.b1 = g.b0 + (size_t)128 * 1024 * 2;
        g.r0 = UNI(tb[32 + e]) + base; g.c0 = pn; g.e = e; g.valid = cnt - base; g.xi = e * 65536 + base;
    }
    __device__ __forceinline__ void first_va(const G8Unit& g, unsigned (&va)[2][2]) const {
        const int t = opaque_tid(wq);
#pragma unroll
        for (int i = 0; i < 2; ++i) { int R, C; stage_rc(t * 16 + i * 8192, R, C);
#pragma unroll
            for (int h = 0; h < 2; ++h) { int pos = 128 * h + R; pos = pos < g.valid ? pos : g.valid - 1; const int tok = toklist[g.xi + pos]; va[h][i] = (unsigned)tok * 2048u + (unsigned)C * 2u; } }
    }
    __device__ __forceinline__ void ids_issue(int par, const G8Unit& n) const {
        const int t = opaque_tid(wq);
        if (t < 256) { int pos = t < n.valid ? t : n.valid - 1; __builtin_amdgcn_global_load_lds((const unsigned*)(toklist + n.xi + pos), (LAS unsigned*)(lds + LDS_IDS + par * 1024 + (t >> 6) * 256), 4, 0, 0); }
    }
    __device__ __forceinline__ void ids_read(int par, unsigned (&va)[2][2]) const {
        const LAS int* ids = (const LAS int*)(lds + LDS_IDS + par * 1024); const int t = opaque_tid(wq);
#pragma unroll
        for (int i = 0; i < 2; ++i) { int R, C; stage_rc(t * 16 + i * 8192, R, C);
#pragma unroll
            for (int h = 0; h < 2; ++h) va[h][i] = (unsigned)ids[128 * h + R] * 2048u + (unsigned)C * 2u; }
    }
    __device__ __forceinline__ void params_issue(int par, const G8Unit& g) const {
        const int t = opaque_tid(wq);
        if (t < 256) __builtin_amdgcn_global_load_lds((const unsigned*)(bgu + g.e * 512 + (t < 128 ? 0 : 128) + 128 * g.c0 + t), (LAS unsigned*)(lds + LDS_PRM + par * 2048 + (t >> 6) * 256), 4, 0, 0);
    }
    __device__ __forceinline__ void epilogue(const f32x4 (&acc)[2][2][4][2], const G8Unit& g, int par) const {
        const int t = opaque_tid(wq), wid = t >> 6, lane = t & 63, wr = wid >> 2, wc = wid & 3, fr = lane & 15, fq = lane >> 4;
        const int actcol = 128 * g.c0 + 32 * wc + 8 * fq;
        const LAS float* bp = (const LAS float*)(lds + LDS_PRM + par * 2048) + 32 * wc + 8 * fq;
        const f32x4 bg0 = *(const LAS f32x4*)bp, bg1 = *(const LAS f32x4*)(bp + 4), bu0 = *(const LAS f32x4*)(bp + 128), bu1 = *(const LAS f32x4*)(bp + 132);
#pragma unroll
        for (int ai = 0; ai < 2; ++ai)
#pragma unroll
            for (int m = 0; m < 4; ++m) {
                const int rloc = 128 * ai + 64 * wr + 16 * m + fr;
                {
                    const size_t orow = rloc < g.valid ? (size_t)(g.r0 + rloc) : (size_t)(NASG + rloc);
                    float o[8];
#pragma unroll
                    for (int n = 0; n < 2; ++n) { const f32x4 gt = acc[ai][0][m][n] + (n ? bg1 : bg0), up = acc[ai][1][m][n] + (n ? bu1 : bu0);
#pragma unroll
                        for (int q = 0; q < 4; ++q) { const float gq = fminf(gt[q], 7.0f), uq = fminf(fmaxf(up[q], -7.0f), 7.0f); o[4 * n + q] = (uq + 1.0f) * (gq * fsigmoid(1.702f * gq)); } }
                    u32x4 w; w.x = cvt_pk_bf16(o[0], o[1]); w.y = cvt_pk_bf16(o[2], o[3]); w.z = cvt_pk_bf16(o[4], o[5]); w.w = cvt_pk_bf16(o[6], o[7]);
                    *(u32x4*)(ACT + orow * 256 + actcol) = w;
                }
            }
    }
};

struct ProbDN8 {
    static constexpr int NK = 4; static constexpr bool GATHER = false; static constexpr bool KROT = false;
    const char* ACT; const char* W; bf16_t* OUT; const float* wlist; const float* bdn; const LAS int* tb; LAS unsigned char* lds; unsigned va0[2], vb[2]; int wq;
    __device__ __forceinline__ void init(const Ctx& X, int layer) {
        wq = X.wid; lds = X.lds;
        ACT = (const char*)(X.ws + WS_ACT); W = (const char*)(X.ws + WS_WB + WB_WDN); OUT = (bf16_t*)(X.ws + WS_R + R_OUT); wlist = (const float*)(X.ws + WS_WL);
        bdn = X.b_dn() + (size_t)layer * NE * 1024; tb = (const LAS int*)(X.lds + LDS_TB); const LaneGeo lg = lane_geo(X);
#pragma unroll
        for (int i = 0; i < 2; ++i) { va0[i] = (unsigned)(lg.R[i] * 256 + lg.C[i]) * 2u; vb[i] = (unsigned)(lg.Rb[i] * 256 + lg.C[i]) * 2u; }
    }
    __device__ __forceinline__ int nunits() const { return tb[97] * 4; }
    __device__ __forceinline__ void decode(int u, G8Unit& g) const {
        const int tile = u >> 2, pn = u & 3; int e, j; moe_find(tb, tile, e, j); e = UNI(e); j = UNI(j);
        const int cnt = UNI(tb[e]), base = 256 * j, row0 = UNI(tb[32 + e]) + base;
        g.a0 = uni_ptr(ACT + (size_t)row0 * 512); g.a1 = g.a0 + (size_t)128 * 512; g.b0 = uni_ptr(W + (size_t)(e * 1024 + 256 * pn) * 256 * 2); g.b1 = g.b0 + (size_t)128 * 256 * 2;
        g.r0 = row0; g.c0 = 256 * pn; g.e = e; g.valid = cnt - base; g.xi = e * 65536 + base;
    }
    __device__ __forceinline__ void first_va(const G8Unit&, unsigned (&va)[2][2]) const {
#pragma unroll
        for (int h = 0; h < 2; ++h)
#pragma unroll
            for (int i = 0; i < 2; ++i) va[h][i] = va0[i]; }
    __device__ __forceinline__ void params_issue(int par, const G8Unit& g) const {
        const int t = opaque_tid(wq);
        if (t < 256) {
            __builtin_amdgcn_global_load_lds((const unsigned*)(bdn + g.e * 1024 + g.c0 + t), (LAS unsigned*)(lds + LDS_PRM + par * 2048 + (t >> 6) * 256), 4, 0, 0);
            __builtin_amdgcn_global_load_lds((const unsigned*)(wlist + g.xi + (t < g.valid ? t : g.valid - 1)), (LAS unsigned*)(lds + LDS_PRM + par * 2048 + 1024 + (t >> 6) * 256), 4, 0, 0);
        }
    }
    __device__ __forceinline__ void epilogue(const f32x4 (&acc)[2][2][4][2], const G8Unit& g, int par) const {
        const int t = opaque_tid(wq), wid = t >> 6, lane = t & 63, wr = wid >> 2, wc = wid & 3, fr = lane & 15, fq = lane >> 4;
        const int col = g.c0 + 32 * wc + 8 * fq;
        const LAS float* bp = (const LAS float*)(lds + LDS_PRM + par * 2048) + 32 * wc + 8 * fq; const LAS float* wp = (const LAS float*)(lds + LDS_PRM + par * 2048 + 1024);
        f32x4 bb[2][2];
#pragma unroll
        for (int bj = 0; bj < 2; ++bj) { bb[bj][0] = *(const LAS f32x4*)(bp + 128 * bj); bb[bj][1] = *(const LAS f32x4*)(bp + 128 * bj + 4); }
        float w8[2][4];
#pragma unroll
        for (int ai = 0; ai < 2; ++ai)
#pragma unroll
            for (int m = 0; m < 4; ++m) { const int rloc = 128 * ai + 64 * wr + 16 * m + fr; w8[ai][m] = wp[rloc]; }
#pragma unroll
        for (int ai = 0; ai < 2; ++ai)
#pragma unroll
            for (int m = 0; m < 4; ++m) {
                const int rloc = 128 * ai + 64 * wr + 16 * m + fr;
                {
                    const size_t orow = rloc < g.valid ? (size_t)(g.r0 + rloc) : (size_t)(NASG + rloc);
                    const float w = w8[ai][m];
#pragma unroll
                    for (int bj = 0; bj < 2; ++bj) { const f32x4 v0 = (acc[ai][bj][m][0] + bb[bj][0]) * w, v1 = (acc[ai][bj][m][1] + bb[bj][1]) * w;
                        u32x4 o; o.x = cvt_pk_bf16(v0[0], v0[1]); o.y = cvt_pk_bf16(v0[2], v0[3]); o.z = cvt_pk_bf16(v1[0], v1[1]); o.w = cvt_pk_bf16(v1[2], v1[3]);
                        *(u32x4*)(OUT + orow * 1024 + col + 128 * bj) = o; }
                }
            }
    }
};

struct ProbMG {
    static constexpr int NK = 18;
    const char* P; const char* BR; const char* WGT; const char* WBR; bf16_t* MG; const float* bgate;
    u32x2 gpk[2][2][4], hpk[2][2][4], mpk[2][2][4]; int wq; LAS unsigned char* ldsb;
    __device__ __forceinline__ void init(const Ctx& X, int layer) {
        wq = X.wid; ldsb = X.lds;
        P = (const char*)(X.ws + WS_R + R_P); BR = (const char*)(X.ws + WS_R + R_BR); WGT = (const char*)(X.ws + WS_WB + WB_WGT); WBR = (const char*)(X.ws + WS_WB + WB_WBR);
        MG = (bf16_t*)(X.ws + WS_R + R_MG); bgate = X.b_gt() + (size_t)layer * 3 * 1024;
#pragma unroll
        for (int a = 0; a < 2; ++a)
#pragma unroll
            for (int m = 0; m < 2; ++m)
#pragma unroll
                for (int n = 0; n < 4; ++n) { gpk[a][m][n] = (u32x2){0u, 0u}; hpk[a][m][n] = (u32x2){0u, 0u}; mpk[a][m][n] = (u32x2){0u, 0u}; }
    }
    __device__ __forceinline__ int nunits() const { return 256 * 8; }
    __device__ __forceinline__ void decode(int u, GUnit& g) const { g.a = nullptr; g.a1 = nullptr; g.b = nullptr; g.r0 = (u >> 3) * 256; g.c0 = (u & 7) * 128; g.e = 0; g.valid = 256; g.xi = 0;
#pragma unroll
        for (int h = 0; h < 2; ++h)
#pragma unroll
            for (int i = 0; i < 2; ++i) g.va[h][i] = 0; }
    __device__ __forceinline__ void issue(LAS unsigned char* lds, unsigned so, unsigned ldsw, const GUnit& g, int kt) const {
        const int i = kt / 6, j = kt - 6 * i; const bool gate = j >= 4; const int jj = gate ? j - 4 : j;
        const int lda = gate ? INWP : 768, ldb = gate ? 128 : 256;
        const char* a = gate ? P + ((size_t)g.r0 * INWP + PC_GC + 128 * i + 64 * jj) * 2 : BR + ((size_t)g.r0 * 768 + 256 * i + 64 * jj) * 2;
        const char* a1 = a + (size_t)128 * lda * 2;
        const char* b = gate ? WGT + ((size_t)(i * 1024 + g.c0) * 128 + 64 * jj) * 2 : WBR + ((size_t)(i * 1024 + g.c0) * 256 + 64 * jj) * 2;
        const int t = opaque_tid(wq);
        unsigned va[2], vb[2];
#pragma unroll
        for (int q = 0; q < 2; ++q) { int R, C; stage_rc(t * 16 + q * 8192, R, C); const int Rb = (R & ~31) + perm32(R & 31); va[q] = (unsigned)(R * lda + C) * 2u; vb[q] = (unsigned)(Rb * ldb + C) * 2u; }
        issue_std(lds, so, ldsw, a, a1, va, va, b, vb);
    }
    __device__ __forceinline__ void params_issue(int par, const GUnit& g) const {
        const int t = opaque_tid(wq);
        if (t < 384) __builtin_amdgcn_global_load_lds((const unsigned*)(bgate + (t >> 7) * 1024 + g.c0 + (t & 127)), (LAS unsigned*)(ldsb + LDS_PRM + par * 2048 + (t >> 6) * 256), 4, 0, 0);
    }
    __device__ __forceinline__ void park_y(f32x4 (&acc)[2][2][4]) {
#pragma unroll
        for (int ai = 0; ai < 2; ++ai)
#pragma unroll
            for (int m = 0; m < 2; ++m)
#pragma unroll
                for (int n = 0; n < 4; ++n) { const f32x4 v = acc[ai][m][n]; gpk[ai][m][n].x = cvt_pk_bf16(v[0], v[1]); gpk[ai][m][n].y = cvt_pk_bf16(v[2], v[3]); }
        zero_acc4(acc);
    }
    __device__ __forceinline__ void park_h(f32x4 (&acc)[2][2][4], int i, int par) {
        const int t = opaque_tid(wq), wid = t >> 6, lane = t & 63, wc2 = wid & 1, fq = lane >> 4;
        const LAS float* bp = (const LAS float*)(ldsb + LDS_PRM + par * 2048) + i * 128 + 64 * wc2 + 8 * fq;
        f32x4 bb[4];
#pragma unroll
        for (int n = 0; n < 4; ++n) bb[n] = *(const LAS f32x4*)(bp + 32 * (n >> 1) + 4 * (n & 1));
#pragma unroll
        for (int ai = 0; ai < 2; ++ai)
#pragma unroll
            for (int m = 0; m < 2; ++m)
#pragma unroll
                for (int n = 0; n < 4; ++n) { const f32x4 v = (acc[ai][m][n] + bb[n]) * -1.4426950408889634f; hpk[ai][m][n].x = cvt_pk_bf16(v[0], v[1]); hpk[ai][m][n].y = cvt_pk_bf16(v[2], v[3]); }
        zero_acc4(acc);
    }
    template <int C>
    __device__ __forceinline__ void chunk(int pi, int pr0, int pc0) {
        constexpr int ai = C >> 1, mm = C & 1;
        const int t = opaque_tid(wq), wid = t >> 6, lane = t & 63, wr4 = wid >> 1, wc2 = wid & 1, fr = lane & 15, fq = lane >> 4;
#pragma unroll
        for (int g = 0; g < 2; ++g) {
#pragma unroll
            for (int n2 = 0; n2 < 2; ++n2) {
                const int n = 2 * g + n2;
                const u32x2 hp = hpk[ai][mm][n];
                const f32x4 gv = sigmoid4_pre((f32x4){bf_lo(hp.x), bf_hi(hp.x), bf_lo(hp.y), bf_hi(hp.y)});
                const u32x2 yp = gpk[ai][mm][n]; const unsigned g0 = cvt_pk_bf16(gv[0], gv[1]), g1 = cvt_pk_bf16(gv[2], gv[3]);
                const u32x2 mp = (pi > 0) ? mpk[ai][mm][n] : (u32x2){0u, 0u};
                mpk[ai][mm][n].x = pk_fma_h2(g0, yp.x, mp.x); mpk[ai][mm][n].y = pk_fma_h2(g1, yp.y, mp.y);
            }
            if (pi == 2) { u32x4 w; w.x = mpk[ai][mm][2 * g].x; w.y = mpk[ai][mm][2 * g].y; w.z = mpk[ai][mm][2 * g + 1].x; w.w = mpk[ai][mm][2 * g + 1].y;
                *(u32x4*)(MG + (size_t)(pr0 + 128 * ai + 32 * wr4 + 16 * mm + fr) * 1024 + pc0 + 64 * wc2 + 32 * g + 8 * fq) = w; }
        }
    }
};

struct CvtTile { const float* src; bf16_t* dst; int ld, k0, n0, dstK, gu; };
__device__ __forceinline__ void cvt_load(const Ctx& X, const CvtTile& t, f32x4 (&v)[2]) {
    const int tid = X.tid, kk = tid >> 4, n4 = tid & 15;
#pragma unroll
    for (int h = 0; h < 2; ++h) v[h] = __builtin_nontemporal_load((const f32x4*)(t.src + (size_t)(t.k0 + kk + 32 * h) * t.ld + t.n0 + 4 * n4));
}
__device__ __forceinline__ void cvt_finish(const Ctx& X, const CvtTile& t, const f32x4 (&v)[2], int buf) {
    LAS float* Tl = (LAS float*)(X.lds + buf * (64 * 65 * 4));
    const int tid = X.tid;
    { const int kk = tid >> 4, n4 = tid & 15;
#pragma unroll
      for (int h = 0; h < 2; ++h) { LAS float* q = Tl + (kk + 32 * h) * 65 + 4 * n4; q[0] = v[h][0]; q[1] = v[h][1]; q[2] = v[h][2]; q[3] = v[h][3]; } }
    __syncthreads();
    { const int n = tid >> 3, kc = tid & 7; float w8[8];
#pragma unroll
      for (int j = 0; j < 8; ++j) w8[j] = Tl[(8 * kc + j) * 65 + n];
      int drow = t.n0 + n;
      if (t.gu) { const int nt = t.n0 >> 6, up = nt >> 2, cidx = 64 * (nt & 3) + n; drow = 256 * (cidx >> 7) + 128 * up + (cidx & 127); }
      u32x4 w; w.x = cvt_pk_bf16(w8[0], w8[1]); w.y = cvt_pk_bf16(w8[2], w8[3]); w.z = cvt_pk_bf16(w8[4], w8[5]); w.w = cvt_pk_bf16(w8[6], w8[7]);
      *(u32x4*)(t.dst + (size_t)drow * t.dstK + t.k0 + 8 * kc) = w; }
}

__device__ __forceinline__ void convert_layer_weights(const Ctx& X, int l) {
    unsigned char* wb = X.ws + WS_WB;
    constexpr int N_IN = 16 * 38, N_BR = 3 * 64, N_GT = 3 * 32, N_OUT = 256, N_GU = 32 * 128, N_DN = 32 * 64;
    constexpr int E0 = N_IN, E1 = E0 + N_BR, E2 = E1 + N_GT, E3 = E2 + N_OUT, E4 = E3 + N_GU, E5 = E4 + N_DN;
    auto decode = [&](int id, CvtTile& t) __attribute__((always_inline)) {
        if (id < E0) { const int kt = id / 38, nt = id - kt * 38; t.src = X.w_in() + (size_t)l * D * INW; t.ld = INW; t.k0 = 64 * kt; t.n0 = 64 * nt; t.dst = (bf16_t*)(wb + WB_WIN); t.dstK = D; t.gu = 0; }
        else if (id < E1) { const int q = id - E0, i = q >> 6, r = q & 63, kt = r >> 4, nt = r & 15; t.src = X.w_br() + (size_t)(l * 3 + i) * 256 * D; t.ld = D; t.k0 = 64 * kt; t.n0 = 64 * nt; t.dst = (bf16_t*)(wb + WB_WBR) + (size_t)i * D * 256; t.dstK = 256; t.gu = 0; }
        else if (id < E2) { const int q = id - E1, i = q >> 5, r = q & 31, kt = r >> 4, nt = r & 15; t.src = X.w_gt() + (size_t)(l * 3 + i) * 128 * D; t.ld = D; t.k0 = 64 * kt; t.n0 = 64 * nt; t.dst = (bf16_t*)(wb + WB_WGT) + (size_t)i * D * 128; t.dstK = 128; t.gu = 0; }
        else if (id < E3) { const int q = id - E2, kt = q >> 4, nt = q & 15; t.src = X.w_out() + (size_t)l * D * D; t.ld = D; t.k0 = 64 * kt; t.n0 = 64 * nt; t.dst = (bf16_t*)(wb + WB_WOUT); t.dstK = D; t.gu = 0; }
        else if (id < E4) { const int q = id - E3, e = q >> 7, r = q & 127, kt = r >> 3, nt = r & 7; t.src = X.w_gu() + (size_t)(l * NE + e) * D * 512; t.ld = 512; t.k0 = 64 * kt; t.n0 = 64 * nt; t.dst = (bf16_t*)(wb + WB_WGU) + (size_t)e * 512 * D; t.dstK = D; t.gu = 1; }
        else { const int q = id - E4, e = q >> 6, r = q & 63, kt = r >> 4, nt = r & 15; t.src = X.w_dn() + (size_t)(l * NE + e) * 256 * D; t.ld = D; t.k0 = 64 * kt; t.n0 = 64 * nt; t.dst = (bf16_t*)(wb + WB_WDN) + (size_t)e * D * 256; t.dstK = 256; t.gu = 0; }
    };
    {
        int id = X.bx; CvtTile tA{}, tB{}; f32x4 vA[2] = {}, vB[2] = {};
        if (id < E5) { decode(id, tA); cvt_load(X, tA, vA); }
        for (;;) {
            if (id >= E5) break;
            { const int idn = id + X.G; if (idn < E5) { decode(idn, tB); cvt_load(X, tB, vB); } cvt_finish(X, tA, vA, 0); id = idn; }
            if (id >= E5) break;
            { const int idn = id + X.G; if (idn < E5) { decode(idn, tA); cvt_load(X, tA, vA); } cvt_finish(X, tB, vB, 1); id = idn; }
        }
        __syncthreads();
    }
    int gsz = X.G * 512; asm volatile("" : "+s"(gsz));
    const int gtid = X.bx * 512 + X.tid;
    { bf16_t* d = (bf16_t*)(wb + WB_WRT); const float* s = X.w_rt() + (size_t)l * D * NE;
      bf16_t* dl = (bf16_t*)(wb + WB_WRTL);
      for (int idx = gtid; idx < NE * D; idx += gsz) { const int e = idx >> 10, k = idx & 1023; const float v = s[k * NE + e]; const unsigned hi = cvt_pk_bf16(v, 0.f) & 0xffffu; d[idx] = (bf16_t)hi; dl[idx] = (bf16_t)(cvt_pk_bf16(v - bf_lo(hi), 0.f) & 0xffffu); } }
    { bf16_t* d = (bf16_t*)(wb + WB_WSP); const float* s = X.w_sp() + (size_t)l * 4 * CH * CH;
      for (int idx = gtid; idx < 4 * CH * CH; idx += gsz) { const int c = (idx >> 7) & 127, m = idx & 127; const float v = (m <= c) ? s[idx] : 0.f; d[idx] = (bf16_t)(cvt_pk_bf16(v, 0.f) & 0xffffu); } }
    { unsigned* d = (unsigned*)(wb + WB_WIN + (size_t)INW * D * 2);
      unsigned z = 0u; asm volatile("" : "+v"(z));
      for (int idx = gtid; idx < (INWP - INW) * D / 2; idx += gsz) d[idx] = z; }
}

__device__ __forceinline__ void phase_ada(const Ctx& X) {
    if (X.bx < 192) {
        LAS float* SC = (LAS float*)X.lds;
        for (int it = 0; it < 64; ++it) { const int idx = it * 512 + X.tid, b = idx & 31, k = idx >> 5; const float cv = X.c()[b * D + k]; SC[idx] = cv * fsigmoid(cv); }
        __syncthreads();
        const int la = X.bx / 48, n0 = (X.bx % 48) * 128, w = X.wid, ks = w >> 1, nh = w & 1;
        const float* wp = X.w_ada() + ((size_t)la * D + 256 * ks) * (6 * D) + n0 + 64 * nh + X.lane;
        float acc[32];
#pragma unroll
        for (int b = 0; b < 32; ++b) acc[b] = 0.f;
#pragma unroll 4
        for (int kk = 0; kk < 256; ++kk) {
            const float wv = wp[(size_t)kk * (6 * D)];
            const LAS f32x4* s4 = (const LAS f32x4*)(SC + (256 * ks + kk) * 32);
#pragma unroll
            for (int b4 = 0; b4 < 8; ++b4) { const f32x4 s = s4[b4];
#pragma unroll
                for (int q = 0; q < 4; ++q) acc[4 * b4 + q] += s[q] * wv; }
        }
        __syncthreads();
        LAS float* RED = (LAS float*)X.lds;
#pragma unroll
        for (int b = 0; b < 32; ++b) RED[(ks * 32 + b) * 128 + 64 * nh + X.lane] = acc[b];
        __syncthreads();
        float* ada = (float*)(X.ws + WS_ADA);
        for (int j = 0; j < 8; ++j) { const int idx = X.tid + 512 * j, b = idx >> 7, n = idx & 127; float s = X.b_ada()[la * 6 * D + n0 + n];
#pragma unroll
            for (int ww = 0; ww < 4; ++ww) s += RED[(ww * 32 + b) * 128 + n];
            ada[((size_t)la * NB + b) * (6 * D) + n0 + n] = s; }
        __syncthreads();
    }
    convert_layer_weights(X, 0);
}

__device__ __forceinline__ void phase_h0(const Ctx& X) {
    const float* ada = (const float*)(X.ws + WS_ADA);
    bf16_t* H = (bf16_t*)(X.ws + WS_H);
    for (size_t g8 = (size_t)X.bx * 512 + X.tid; g8 < (size_t)T * (D / 8); g8 += (size_t)X.G * 512) {
        const int t = (int)(g8 >> 7), c8 = (int)(g8 & 127) * 8, b = t >> 11;
        const float* xr = X.x() + (size_t)t * D + c8; const float* sh = ada + (size_t)b * 6 * D + c8; const float* sc = sh + D;
        const f32x4 x0 = *(const f32x4*)xr, x1 = *(const f32x4*)(xr + 4), s0 = *(const f32x4*)sh, s1 = *(const f32x4*)(sh + 4), c0 = *(const f32x4*)sc, c1 = *(const f32x4*)(sc + 4);
        const f32x4 h0 = x0 * (c0 + 1.0f) + s0, h1 = x1 * (c1 + 1.0f) + s1;
        u32x4 w; w.x = cvt_pk_bf16(h0[0], h0[1]); w.y = cvt_pk_bf16(h0[2], h0[3]); w.z = cvt_pk_bf16(h1[0], h1[1]); w.w = cvt_pk_bf16(h1[2], h1[3]);
        *(u32x4*)(H + (size_t)t * D + c8) = w;
        u32x4 xw; xw.x = cvt_pk_bf16(x0[0], x0[1]); xw.y = cvt_pk_bf16(x0[2], x0[3]); xw.z = cvt_pk_bf16(x1[0], x1[1]); xw.w = cvt_pk_bf16(x1[2], x1[3]);
        *(u32x4*)((bf16_t*)(X.ws + WS_X16) + (size_t)t * D + c8) = xw;
    }
}

__device__ __forceinline__ float log2gamma(int h) { return h == 0 ? -0.04580368961312479f : h == 1 ? -0.02272007650008353f : h == 2 ? -0.011315313227834146f : -0.005646563141142063f; }
constexpr int VT_PITCH = 288;
__device__ __forceinline__ int vt_sw(int row) { return ((row >> 2) ^ (row >> 4)) & 7; }
__device__ __forceinline__ int vt_elem(int row, int m) { return row * (VT_PITCH / 2) + ((((m >> 3) ^ vt_sw(row)) << 3) | (m & 7)); }
__device__ __forceinline__ int vt_byte(int row, int kc) { return row * VT_PITCH + ((kc ^ vt_sw(row)) << 4); }

__device__ __forceinline__ void rotary8(const u32x4& a, const u32x4& b, float pos, int i0, float scale, float (&o1)[8], float (&o2)[8]) {
    float t1[8] = {bf_lo(a.x), bf_hi(a.x), bf_lo(a.y), bf_hi(a.y), bf_lo(a.z), bf_hi(a.z), bf_lo(a.w), bf_hi(a.w)};
    float t2[8] = {bf_lo(b.x), bf_hi(b.x), bf_lo(b.y), bf_hi(b.y), bf_lo(b.z), bf_hi(b.z), bf_lo(b.w), bf_hi(b.w)};
#pragma unroll
    for (int j = 0; j < 8; ++j) {
        const float invf = exp2f(-(float)(i0 + j) * 0.8304820237218405f);
        const float rev = __builtin_amdgcn_fractf(pos * invf * 0.15915494309189535f); const float sn = __builtin_amdgcn_sinf(rev), cs = __builtin_amdgcn_cosf(rev);
        o1[j] = (t1[j] * cs - t2[j] * sn) * scale; o2[j] = (t2[j] * cs + t1[j] * sn) * scale;
    }
}

__device__ __forceinline__ void phase_mixA(const Ctx& X, int layer) {
    const bf16_t* P = (const bf16_t*)(X.ws + WS_R + R_P);
    bf16_t* BR = (bf16_t*)(X.ws + WS_R + R_BR);
    float* KV = (float*)(X.ws + WS_KV);
    LAS unsigned char* lds = X.lds;
    LAS bf16_t* KrT = (LAS bf16_t*)lds;
    LAS bf16_t* VT = (LAS bf16_t*)(lds + 128 * VT_PITCH);
    for (int u = X.bx; u < NB * NCH; u += X.G) {
        const int b = u >> 4, n = u & 15, t0 = b * SEQ + n * CH;
        const int tid = opaque_tid(X.wid), lane = tid & 63, w = X.wid, fr = lane & 15, fq = lane >> 4;
#pragma unroll
        for (int it = 0; it < 2; ++it) {
            const int id = it * 512 + tid, m = id >> 3, hg = id & 7, h = hg >> 1, g = hg & 1;
            const bf16_t* rp = P + (size_t)(t0 + m) * INWP + PC_RK + 32 * h + 8 * g;
            const u32x4 a = *(const u32x4*)rp, bb = *(const u32x4*)(rp + 16);
            const float pos = (float)X.pos()[t0 + m];
            const float zeta = exp2f(log2gamma(h) * (float)(CH - 1 - m)) * 0.1767766952966369f;
            float o1[8], o2[8]; rotary8(a, bb, pos, 8 * g, zeta, o1, o2);
#pragma unroll
            for (int j = 0; j < 8; ++j) { KrT[vt_elem(h * 32 + 8 * g + j, m)] = (bf16_t)(cvt_pk_bf16(o1[j], 0.f) & 0xffffu); KrT[vt_elem(h * 32 + 16 + 8 * g + j, m)] = (bf16_t)(cvt_pk_bf16(o2[j], 0.f) & 0xffffu); }
        }
#pragma unroll
        for (int it = 0; it < 8; ++it) {
            const int m = 32 * (it >> 1) + (tid >> 4), cg = (tid & 15) + 16 * (it & 1);
            const u32x4 a = *(const u32x4*)(P + (size_t)(t0 + m) * INWP + PC_RV + 8 * cg);
            const unsigned ww[4] = {a.x, a.y, a.z, a.w};
#pragma unroll
            for (int j = 0; j < 4; ++j) { VT[vt_elem(8 * cg + 2 * j, m)] = (bf16_t)(ww[j] & 0xffffu); VT[vt_elem(8 * cg + 2 * j + 1, m)] = (bf16_t)(ww[j] >> 16); }
        }
        __syncthreads();
        {
            const int h = w >> 1, it = w & 1;
            f32x4 acc[4];
#pragma unroll
            for (int jt = 0; jt < 4; ++jt) acc[jt] = (f32x4){0.f, 0.f, 0.f, 0.f};
#pragma unroll
            for (int ks = 0; ks < 4; ++ks) {
                const bf16x8 kf = *(const LAS bf16x8*)((LAS unsigned char*)KrT + vt_byte(h * 32 + 16 * it + fr, 4 * ks + fq));
#pragma unroll
                for (int jt = 0; jt < 4; ++jt) { const bf16x8 vf = *(const LAS bf16x8*)((LAS unsigned char*)VT + vt_byte(64 * h + 16 * jt + fr, 4 * ks + fq)); acc[jt] = MFMA16(kf, vf, acc[jt]); }
            }
            float* kvp = KV + ((size_t)(b * NCH + n) * 4 + h) * 2048;
#pragma unroll
            for (int jt = 0; jt < 4; ++jt) *(f32x4*)(kvp + (16 * jt + fr) * 32 + 16 * it + 4 * fq) = acc[jt];
        }
        {
            const int cg = tid & 31, seg = tid >> 5, c8 = 8 * cg;
            const float* cw = X.conv_w() + (size_t)layer * 3 * 256 + c8;
            float w0[8], w1[8], w2[8];
#pragma unroll
            for (int j = 0; j < 8; ++j) { w0[j] = cw[j]; w1[j] = cw[256 + j]; w2[j] = cw[512 + j]; }
            float z1[8], z2[8];
            const int s0 = n * CH + 8 * seg;
#pragma unroll
            for (int q = 0; q < 2; ++q) {
                const int sp = s0 - 2 + q; float zz[8];
                if (sp >= 0) { const bf16_t* rp = P + (size_t)(b * SEQ + sp) * INWP; const u32x4 cc = *(const u32x4*)(rp + PC_CC + c8), cx = *(const u32x4*)(rp + PC_CX + c8);
                    const unsigned c_[4] = {cc.x, cc.y, cc.z, cc.w}, x_[4] = {cx.x, cx.y, cx.z, cx.w};
#pragma unroll
                    for (int j = 0; j < 4; ++j) { zz[2 * j] = bf_lo(c_[j]) * bf_lo(x_[j]); zz[2 * j + 1] = bf_hi(c_[j]) * bf_hi(x_[j]); } }
                else {
#pragma unroll
                    for (int j = 0; j < 8; ++j) zz[j] = 0.f; }
#pragma unroll
                for (int j = 0; j < 8; ++j) { if (q == 0) z2[j] = zz[j]; else z1[j] = zz[j]; }
            }
            u32x4 cbv[8], ccv[8], cxv[8];
#pragma unroll
            for (int tt = 0; tt < 8; ++tt) { const bf16_t* rp = P + (size_t)(t0 + 8 * seg + tt) * INWP; cbv[tt] = __builtin_nontemporal_load((const u32x4*)(rp + PC_CB + c8)); ccv[tt] = __builtin_nontemporal_load((const u32x4*)(rp + PC_CC + c8)); cxv[tt] = __builtin_nontemporal_load((const u32x4*)(rp + PC_CX + c8)); }
#pragma unroll
            for (int tt = 0; tt < 8; ++tt) {
                const int t = t0 + 8 * seg + tt;
                const u32x4 cb = cbv[tt], cc = ccv[tt], cx = cxv[tt];
                const unsigned b_[4] = {cb.x, cb.y, cb.z, cb.w}, c_[4] = {cc.x, cc.y, cc.z, cc.w}, x_[4] = {cx.x, cx.y, cx.z, cx.w};
                float z0[8], o[8];
#pragma unroll
                for (int j = 0; j < 4; ++j) { z0[2 * j] = bf_lo(c_[j]) * bf_lo(x_[j]); z0[2 * j + 1] = bf_hi(c_[j]) * bf_hi(x_[j]); }
#pragma unroll
                for (int j = 0; j < 4; ++j) { o[2 * j] = bf_lo(b_[j]) * (w0[2 * j] * z2[2 * j] + w1[2 * j] * z1[2 * j] + w2[2 * j] * z0[2 * j]);
                    o[2 * j + 1] = bf_hi(b_[j]) * (w0[2 * j + 1] * z2[2 * j + 1] + w1[2 * j + 1] * z1[2 * j + 1] + w2[2 * j + 1] * z0[2 * j + 1]); }
                u32x4 ow; ow.x = cvt_pk_bf16(o[0], o[1]); ow.y = cvt_pk_bf16(o[2], o[3]); ow.z = cvt_pk_bf16(o[4], o[5]); ow.w = cvt_pk_bf16(o[6], o[7]);
                *(u32x4*)(BR + (size_t)t * 768 + 512 + c8) = ow;
#pragma unroll
                for (int j = 0; j < 8; ++j) { z2[j] = z1[j]; z1[j] = z0[j]; }
            }
        }
        __syncthreads();
    }
}

__device__ __forceinline__ void phase_mixB(const Ctx& X, int layer) {
    const bf16_t* P = (const bf16_t*)(X.ws + WS_R + R_P);
    bf16_t* BR = (bf16_t*)(X.ws + WS_R + R_BR);
    const float* KV = (const float*)(X.ws + WS_KV);
    const bf16_t* WSP = (const bf16_t*)(X.ws + WS_WB + WB_WSP);
    LAS unsigned char* lds = X.lds;
    constexpr int QL_P = 160, ST_P = 96;
    constexpr int OFF_QL = 0, OFF_KL = OFF_QL + 128 * QL_P, OFF_VT = OFF_KL + 128 * QL_P, OFF_STL = OFF_VT + 128 * VT_PITCH, OFF_PW = OFF_STL + 128 * ST_P;
    static_assert(OFF_PW + 8 * 16 * VT_PITCH <= LDS_MAIN, "mixB LDS");
    u32x4 pqa[2], pqb[2], pva[4], pgv[8];
#define MB_LOAD_PASS(pp, tb_) do { const int tl_ = opaque_tid(X.wid); const int m_ = tl_ >> 2, hg_ = tl_ & 3, h_ = 2 * (pp) + (hg_ >> 1), g_ = hg_ & 1; \
    _Pragma("unroll") for (int it = 0; it < 2; ++it) { const bf16_t* rp = P + (size_t)((tb_) + m_) * INWP + (it == 0 ? PC_RQ : PC_RK) + 32 * h_ + 8 * g_; \
        pqa[it] = __builtin_nontemporal_load((const u32x4*)rp); pqb[it] = __builtin_nontemporal_load((const u32x4*)(rp + 16)); } \
    _Pragma("unroll") for (int it = 0; it < 4; ++it) { const int id_ = it * 512 + tl_, m2_ = id_ >> 4, cg_ = id_ & 15; \
        pva[it] = __builtin_nontemporal_load((const u32x4*)(P + (size_t)((tb_) + m2_) * INWP + PC_RV + 128 * (pp) + 8 * cg_)); } } while (0)
    bool have = false;
    for (int uu = X.bx; uu < NB * NCH; uu += X.G) {
        const int u = (uu & 256) ? (uu ^ 15) : uu;
        const int b = u >> 4, n = u & 15, t0 = b * SEQ + n * CH;
        if (!have) MB_LOAD_PASS(0, t0);
        for (int p = 0; p < 2; ++p) {
            const int tid = opaque_tid(X.wid), lane = tid & 63, w = (X.wid < 4) ? X.wid : 11 - X.wid, fr = lane & 15, fq = lane >> 4;
#pragma unroll
            for (int it = 0; it < 2; ++it) {
                const int m = tid >> 2, hg = tid & 3, hh = hg >> 1, g = hg & 1, h = 2 * p + hh;
                const u32x4 a = pqa[it], bb = pqb[it];
                const float pos = (float)X.pos()[t0 + m];
                float o1[8], o2[8]; rotary8(a, bb, pos, 8 * g, it == 0 ? 1.0f : 0.1767766952966369f, o1, o2);
                u32x4 w1, w2; w1.x = cvt_pk_bf16(o1[0], o1[1]); w1.y = cvt_pk_bf16(o1[2], o1[3]); w1.z = cvt_pk_bf16(o1[4], o1[5]); w1.w = cvt_pk_bf16(o1[6], o1[7]);
                w2.x = cvt_pk_bf16(o2[0], o2[1]); w2.y = cvt_pk_bf16(o2[2], o2[3]); w2.z = cvt_pk_bf16(o2[4], o2[5]); w2.w = cvt_pk_bf16(o2[6], o2[7]);
                LAS unsigned char* dst = lds + (it == 0 ? OFF_QL : OFF_KL) + m * QL_P + (32 * hh + 8 * g) * 2;
                *(LAS u32x4*)dst = w1; *(LAS u32x4*)(dst + 32) = w2;
            }
#pragma unroll
            for (int it = 0; it < 4; ++it) {
                const int id = it * 512 + tid, m = id >> 4, cg = id & 15;
                const u32x4 a = pva[it];
                const unsigned ww[4] = {a.x, a.y, a.z, a.w};
                LAS bf16_t* vt = (LAS bf16_t*)(lds + OFF_VT);
#pragma unroll
                for (int j = 0; j < 4; ++j) { vt[vt_elem(8 * cg + 2 * j, m)] = (bf16_t)(ww[j] & 0xffffu); vt[vt_elem(8 * cg + 2 * j + 1, m)] = (bf16_t)(ww[j] >> 16); }
            }
            {
                const int q4a = tid * 2, dvl = q4a >> 3, dk4 = q4a & 7, h = 2 * p + (dvl >> 6);
                const float lgc = log2gamma(h) * 128.0f;
                const float* kvb = KV + ((size_t)(b * NCH) * 4 + h) * 2048 + (dvl & 63) * 32 + 4 * dk4;
                f32x4 s0 = (f32x4){0.f, 0.f, 0.f, 0.f}, s1 = s0;
#pragma unroll
                for (int jb = 0; jb < 16; jb += 8) {
                    if (jb < n) {
                        f32x4 k0[8], k1[8];
#pragma unroll
                        for (int jj = 0; jj < 8; ++jj) { const int j = jb + jj; const int jc = j < n ? j : 0; k0[jj] = *(const f32x4*)(kvb + (size_t)jc * 4 * 2048); k1[jj] = *(const f32x4*)(kvb + (size_t)jc * 4 * 2048 + 4); }
#pragma unroll
                        for (int jj = 0; jj < 8; ++jj) { const int j = jb + jj; const float wj = j < n ? exp2f(lgc * (float)(n - 1 - j)) : 0.f; s0 += k0[jj] * wj; s1 += k1[jj] * wj; }
                    }
                }
                u32x4 o; o.x = cvt_pk_bf16(s0[0], s0[1]); o.y = cvt_pk_bf16(s0[2], s0[3]); o.z = cvt_pk_bf16(s1[0], s1[1]); o.w = cvt_pk_bf16(s1[2], s1[3]);
                *(LAS u32x4*)(lds + OFF_STL + dvl * ST_P + 8 * dk4) = o;
            }
            __syncthreads();
            if (p == 0) MB_LOAD_PASS(1, t0);
            else {
                const int tg_ = opaque_tid(X.wid);
#pragma unroll
                for (int i = 0; i < 8; ++i) pgv[i] = *(const u32x4*)(P + (size_t)(t0 + (tg_ >> 2)) * INWP + PC_GV + 8 * (4 * i + (tg_ & 3)));
            }
            for (int hh = 0; hh < 2; ++hh) {
                const int h = 2 * p + hh; const float lg2 = log2gamma(h);
                const bf16x8 qf = *(const LAS bf16x8*)(lds + OFF_QL + (16 * w + fr) * QL_P + (32 * hh + 8 * fq) * 2);
                LAS unsigned char* pw = lds + OFF_PW + w * 16 * VT_PITCH;
                u32x2 gwv[4];
#pragma unroll
                for (int jt = 0; jt < 4; ++jt) gwv[jt] = __builtin_nontemporal_load((const u32x2*)(P + (size_t)(t0 + 16 * w + fr) * INWP + PC_RG + 64 * h + 16 * jt + 4 * fq));
                float lf[4];
#pragma unroll
                for (int r = 0; r < 4; ++r) lf[r] = __builtin_amdgcn_exp2f(lg2 * (float)(fr - 4 * fq - r));
#pragma unroll
                for (int mb = 0; mb < 8; ++mb) {
                    if (mb <= w) {
                        const bf16x8 kf = *(const LAS bf16x8*)(lds + OFF_KL + (16 * mb + fr) * QL_P + (32 * hh + 8 * fq) * 2);
                        const f32x4 s = MFMA16(kf, qf, ((f32x4){0.f, 0.f, 0.f, 0.f}));
                        const float bsc = __builtin_amdgcn_exp2f(lg2 * (float)(16 * (w - mb)));
                        float v[4];
#pragma unroll
                        for (int r = 0; r < 4; ++r) { const int d = (16 * w + fr) - (16 * mb + 4 * fq + r); v[r] = d >= 0 ? s[r] * (bsc * lf[r]) : 0.f; }
                        u32x2 o; o.x = cvt_pk_bf16(v[0], v[1]); o.y = cvt_pk_bf16(v[2], v[3]);
                        *(LAS u32x2*)(pw + fr * VT_PITCH + (16 * mb + 4 * fq) * 2) = o;
                    } else if (mb == w + 1 && (w & 1) == 0) {
                        *(LAS u32x2*)(pw + fr * VT_PITCH + (16 * mb + 4 * fq) * 2) = (u32x2){0u, 0u};
                    }
                }
                WAIT_L0(); __builtin_amdgcn_wave_barrier();
                f32x4 ao[4], ax[4];
#pragma unroll
                for (int jt = 0; jt < 4; ++jt) { ao[jt] = (f32x4){0.f, 0.f, 0.f, 0.f}; ax[jt] = (f32x4){0.f, 0.f, 0.f, 0.f}; }
                const int nks = (w >> 1) + 1;
#pragma unroll
                for (int ks = 0; ks < 4; ++ks) {
                    if (ks < nks) {
                        const bf16x8 pf = *(const LAS bf16x8*)(pw + fr * VT_PITCH + (32 * ks + 8 * fq) * 2);
#pragma unroll
                        for (int jt = 0; jt < 4; ++jt) { const bf16x8 vf = *(const LAS bf16x8*)(lds + OFF_VT + vt_byte(64 * hh + 16 * jt + fr, 4 * ks + fq)); ao[jt] = MFMA16(vf, pf, ao[jt]); }
                    }
                }
#pragma unroll
                for (int jt = 0; jt < 4; ++jt) { const bf16x8 sf = *(const LAS bf16x8*)(lds + OFF_STL + (64 * hh + 16 * jt + fr) * ST_P + 8 * fq * 2); ax[jt] = MFMA16(sf, qf, ax[jt]); }
                const int cl = 16 * w + fr; const float xi = exp2f(lg2 * (float)(cl + 1));
                float o[4][4]; float sum = 0.f;
#pragma unroll
                for (int jt = 0; jt < 4; ++jt)
#pragma unroll
                    for (int r = 0; r < 4; ++r) { o[jt][r] = ao[jt][r] + xi * ax[jt][r]; sum += o[jt][r]; }
                sum += __shfl_xor(sum, 16); sum += __shfl_xor(sum, 32);
                const float mu = sum * (1.0f / 64.0f); float sq = 0.f;
#pragma unroll
                for (int jt = 0; jt < 4; ++jt)
#pragma unroll
                    for (int r = 0; r < 4; ++r) { const float d = o[jt][r] - mu; sq += d * d; }
                sq += __shfl_xor(sq, 16); sq += __shfl_xor(sq, 32);
                const float rstd = rsqrtf(sq * (1.0f / 64.0f) + LN_EPS);
                const size_t t = (size_t)(t0 + cl);
#pragma unroll
                for (int jt = 0; jt < 4; ++jt) {
                    const u32x2 gw = gwv[jt];
                    const float gg[4] = {bf_lo(gw.x), bf_hi(gw.x), bf_lo(gw.y), bf_hi(gw.y)}; float r4[4];
#pragma unroll
                    for (int r = 0; r < 4; ++r) r4[r] = gg[r] * fsigmoid(gg[r]) * ((o[jt][r] - mu) * rstd);
                    u32x2 ow; ow.x = cvt_pk_bf16(r4[0], r4[1]); ow.y = cvt_pk_bf16(r4[2], r4[3]);
                    *(u32x2*)(BR + t * 768 + 64 * h + 16 * jt + 4 * fq) = ow;
                }
                WAIT_L0(); __builtin_amdgcn_wave_barrier();
            }
            __syncthreads();
        }
        {
            const int tid = opaque_tid(X.wid);
            LAS bf16_t* vt2 = (LAS bf16_t*)lds;
            const int m = tid >> 2, qd = tid & 3; const size_t t = (size_t)(t0 + m);
            float sum = 0.f, sq = 0.f;
            float gv[8][8];
#pragma unroll
            for (int i = 0; i < 8; ++i) {
                const u32x4 a = pgv[i];
                const unsigned ww[4] = {a.x, a.y, a.z, a.w};
#pragma unroll
                for (int j = 0; j < 4; ++j) { const float v0 = gelu_tanh(bf_lo(ww[j])), v1 = gelu_tanh(bf_hi(ww[j])); gv[i][2 * j] = v0; gv[i][2 * j + 1] = v1; sum += v0 + v1; sq += v0 * v0 + v1 * v1; }
            }
            DPP_ADD(sum, 0xB1, 0xf); DPP_ADD(sum, 0x4E, 0xf); DPP_ADD(sq, 0xB1, 0xf); DPP_ADD(sq, 0x4E, 0xf);
            const float mu = sum * (1.0f / 256.0f); const float var = fmaxf(sq * (1.0f / 256.0f) - mu * mu, 0.f);
            const float rstd = rsqrtf(var + LN_EPS);
            const float* lg_ = X.gln_g() + layer * 256; const float* lb_ = X.gln_b() + layer * 256;
#pragma unroll
            for (int i = 0; i < 8; ++i) {
                const int c0 = 8 * (4 * i + qd);
                const f32x4 lga = *(const f32x4*)(lg_ + c0), lgb = *(const f32x4*)(lg_ + c0 + 4), lba = *(const f32x4*)(lb_ + c0), lbb = *(const f32x4*)(lb_ + c0 + 4);
                const float lgv[8] = {lga[0], lga[1], lga[2], lga[3], lgb[0], lgb[1], lgb[2], lgb[3]}, lbv[8] = {lba[0], lba[1], lba[2], lba[3], lbb[0], lbb[1], lbb[2], lbb[3]};
#pragma unroll
                for (int j = 0; j < 4; ++j) {
                    const float v0 = (gv[i][2 * j] - mu) * rstd * lgv[2 * j] + lbv[2 * j], v1 = (gv[i][2 * j + 1] - mu) * rstd * lgv[2 * j + 1] + lbv[2 * j + 1];
                    const unsigned pk = cvt_pk_bf16(v0, v1);
                    vt2[vt_elem(c0 + 2 * j, m)] = (bf16_t)(pk & 0xffffu); vt2[vt_elem(c0 + 2 * j + 1, m)] = (bf16_t)(pk >> 16);
                }
                if (i & 1) __builtin_amdgcn_sched_barrier(0);
            }
        }
        __syncthreads();
        {
            const int tid = opaque_tid(X.wid), lane = tid & 63, w = (X.wid < 4) ? X.wid : 11 - X.wid, fr = lane & 15, fq = lane >> 4;
            const int nks = (w >> 1) + 1; const int cl = 16 * w + fr; const size_t t = (size_t)(t0 + cl);
            { const int un_ = uu + X.G; have = un_ < NB * NCH; if (have) { const int u2_ = (un_ & 256) ? (un_ ^ 15) : un_; MB_LOAD_PASS(0, (u2_ >> 4) * SEQ + (u2_ & 15) * CH); } }
            bf16x8 wfa[4][4]; u32x2 uwa[4][4];
#pragma unroll
            for (int g = 0; g < 4; ++g) {
#pragma unroll
                for (int ks = 0; ks < 4; ++ks) wfa[g][ks] = *(const bf16x8*)(WSP + ((size_t)g * CH + cl) * CH + 32 * (ks < nks ? ks : 0) + 8 * fq);
#pragma unroll
                for (int jt = 0; jt < 4; ++jt) uwa[g][jt] = __builtin_nontemporal_load((const u32x2*)(P + t * INWP + PC_GU + 64 * g + 16 * jt + 4 * fq));
            }
#pragma unroll
            for (int g = 0; g < 4; ++g) {
                f32x4 acc[4];
#pragma unroll
                for (int jt = 0; jt < 4; ++jt) acc[jt] = (f32x4){0.f, 0.f, 0.f, 0.f};
#pragma unroll
                for (int ks = 0; ks < 4; ++ks) {
                    if (ks < nks) {
                        const bf16x8 wf = wfa[g][ks];
#pragma unroll
                        for (int jt = 0; jt < 4; ++jt) { const bf16x8 vf = *(const LAS bf16x8*)(lds + vt_byte(64 * g + 16 * jt + fr, 4 * ks + fq)); acc[jt] = MFMA16(vf, wf, acc[jt]); }
                    }
                }
                const float bs = X.b_sp()[(size_t)layer * 4 * CH + g * CH + cl];
#pragma unroll
                for (int jt = 0; jt < 4; ++jt) {
                    const u32x2 uw = uwa[g][jt];
                    const float uu[4] = {bf_lo(uw.x), bf_hi(uw.x), bf_lo(uw.y), bf_hi(uw.y)}; float r4[4];
#pragma unroll
                    for (int r = 0; r < 4; ++r) r4[r] = gelu_tanh(uu[r]) * (acc[jt][r] + bs);
                    u32x2 ow; ow.x = cvt_pk_bf16(r4[0], r4[1]); ow.y = cvt_pk_bf16(r4[2], r4[3]);
                    *(u32x2*)(BR + t * 768 + 256 + 64 * g + 16 * jt + 4 * fq) = ow;
                }
            }
        }
        __syncthreads();
    }
#undef MB_LOAD_PASS
}

__device__ __forceinline__ void phase_ln1(const Ctx& X, int layer) {
    bf16_t* X16 = (bf16_t*)(X.ws + WS_X16);
    const bf16_t* MIX = (const bf16_t*)(X.ws + WS_R + R_MIX);
    bf16_t* H = (bf16_t*)(X.ws + WS_H);
    const bf16_t* WRT = (const bf16_t*)(X.ws + WS_WB + WB_WRT); const bf16_t* WRTL = (const bf16_t*)(X.ws + WS_WB + WB_WRTL);
    const float* ada = (const float*)(X.ws + WS_ADA) + (size_t)layer * NB * 6 * D;
    unsigned* cntg = (unsigned*)(X.ws + WS_CTRL + CTRL_CNT) + layer * 32;
    int* toklist = (int*)(X.ws + WS_TOKL); float* wlist = (float*)(X.ws + WS_WL); unsigned* topi = (unsigned*)(X.ws + WS_TOPI);
    LAS unsigned char* lds = X.lds;
    constexpr int HL_P = 2064;
    constexpr int OFF_HL = 0, OFF_LG = OFF_HL + 16 * HL_P, OFF_AE = OFF_LG + 8 * 16 * 32 * 4, OFF_AR = OFF_AE + 1024 * 4, OFF_AW = OFF_AR + 1024 * 4, OFF_HIST = OFF_AW + 1024 * 4, OFF_BASE = OFF_HIST + 128, OFF_CST = OFF_BASE + 128, OFF_HL2 = OFF_CST + 5 * D * 4, OFF_LGT = OFF_HL2 + 16 * HL_P;
    LAS float* CST = (LAS float*)(lds + OFF_CST);
    LAS float* LG = (LAS float*)(lds + OFF_LG); LAS float* LGT = (LAS float*)(lds + OFF_LGT);
    static_assert(OFF_LGT + 256 * 33 * 4 <= LDS_XB, "ln1 LDS (runs into the table area behind LDS_MAIN, which LN1 does not use)");
    LAS int* AE = (LAS int*)(lds + OFF_AE); LAS int* AR = (LAS int*)(lds + OFF_AR); LAS float* AW = (LAS float*)(lds + OFF_AW);
    LAS int* HIST = (LAS int*)(lds + OFF_HIST); LAS int* BASE = (LAS int*)(lds + OFF_BASE);
    const int tid = X.tid, lane = X.lane, w = X.wid, fr = lane & 15, fq = lane >> 4;
    for (int blk = X.bx; blk < T / 256; blk += X.G) {
        const int tb0 = blk * 256, b = tb0 >> 11;
        if (tid < 32) HIST[tid] = 0;
        for (int i = tid; i < 5 * D; i += 512) { const int v = i >> 10, col = i & 1023; float val;
            if (v == 0) val = 1.0f + ada[(size_t)b * 6 * D + 2 * D + col]; else if (v == 1) val = 1.0f + ada[(size_t)b * 6 * D + 4 * D + col]; else if (v == 2) val = ada[(size_t)b * 6 * D + 3 * D + col];
            else if (v == 3) val = X.ln1_g()[layer * D + col]; else val = X.ln1_b()[layer * D + col];
            CST[i] = val; }
        __syncthreads();
        bf16x8 rw0[4], rw1[4], rl0[4], rl1[4];
#pragma unroll
        for (int ks = 0; ks < 4; ++ks) { const int k0 = 128 * w + 32 * ks + 8 * fq;
            rw0[ks] = *(const bf16x8*)(WRT + (size_t)fr * D + k0); rw1[ks] = *(const bf16x8*)(WRT + (size_t)(16 + fr) * D + k0);
            rl0[ks] = *(const bf16x8*)(WRTL + (size_t)fr * D + k0); rl1[ks] = *(const bf16x8*)(WRTL + (size_t)(16 + fr) * D + k0); }
        const float brt_e = X.b_rt()[layer * NE + (opaque_tid(w) & 31)];
        u32x4 cxr[2][2], cmr[2][2], nxr[2][2], nmr[2][2];
#define LN1_LOAD2(xx, mm, st_) do { _Pragma("unroll") for (int q = 0; q < 2; ++q) { const size_t _t = (size_t)(tb0 + 16 * (st_) + 2 * w + q); _Pragma("unroll") for (int hf = 0; hf < 2; ++hf) { \
            xx[q][hf] = __builtin_nontemporal_load((const u32x4*)(X16 + _t * D + 512 * hf + 8 * lane)); mm[q][hf] = __builtin_nontemporal_load((const u32x4*)(MIX + _t * D + 512 * hf + 8 * lane)); } } } while (0)
        LN1_LOAD2(cxr, cmr, 0);
#pragma nounroll
        for (int st = 0; st < 16; ++st) {
            { const int stn = st < 15 ? st + 1 : 15; LN1_LOAD2(nxr, nmr, stn); }
#pragma unroll
            for (int q = 0; q < 2; ++q) {
                const int tl = 2 * w + q; const size_t t = (size_t)(tb0 + 16 * st + tl);
                float v[16];
#pragma unroll
                for (int hf = 0; hf < 2; ++hf) {
                    const int col = 512 * hf + 8 * lane;
                    const u32x4 xw = cxr[q][hf]; const f32x4 x0 = (f32x4){bf_lo(xw.x), bf_hi(xw.x), bf_lo(xw.y), bf_hi(xw.y)}, x1 = (f32x4){bf_lo(xw.z), bf_hi(xw.z), bf_lo(xw.w), bf_hi(xw.w)};
                    const u32x4 mw = cmr[q][hf];
                    const f32x4 g0 = *(const LAS f32x4*)(CST + col), g1 = *(const LAS f32x4*)(CST + col + 4);
                    const float mm[8] = {bf_lo(mw.x), bf_hi(mw.x), bf_lo(mw.y), bf_hi(mw.y), bf_lo(mw.z), bf_hi(mw.z), bf_lo(mw.w), bf_hi(mw.w)};
#pragma unroll
                    for (int j = 0; j < 4; ++j) { v[8 * hf + j] = DN_ALPHA * x0[j] + g0[j] * mm[j]; v[8 * hf + 4 + j] = DN_ALPHA * x1[j] + g1[j] * mm[4 + j]; }
                }
                float s = 0.f;
#pragma unroll
                for (int j = 0; j < 16; ++j) s += v[j];
                const float mu = wave_sum(s) * (1.0f / 1024.0f); float sq = 0.f;
#pragma unroll
                for (int j = 0; j < 16; ++j) { const float d = v[j] - mu; sq += d * d; }
                const float rstd = rsqrtf(wave_sum(sq) * (1.0f / 1024.0f) + LN_EPS);
#pragma unroll
                for (int hf = 0; hf < 2; ++hf) {
                    const int col = 512 * hf + 8 * lane; float h2[8]; f32x4 xs[2];
#pragma unroll
                    for (int q4 = 0; q4 < 2; ++q4) {
                        const f32x4 lg4 = *(const LAS f32x4*)(CST + 3 * D + col + 4 * q4), lb4 = *(const LAS f32x4*)(CST + 4 * D + col + 4 * q4);
                        const f32x4 sc4 = *(const LAS f32x4*)(CST + D + col + 4 * q4), sh4 = *(const LAS f32x4*)(CST + 2 * D + col + 4 * q4);
                        f32x4 xo;
#pragma unroll
                        for (int j = 0; j < 4; ++j) { xo[j] = (v[8 * hf + 4 * q4 + j] - mu) * rstd * lg4[j] + lb4[j]; h2[4 * q4 + j] = xo[j] * sc4[j] + sh4[j]; }
                        xs[q4] = xo;
                    }
                    { u32x4 xw; xw.x = cvt_pk_bf16(xs[0][0], xs[0][1]); xw.y = cvt_pk_bf16(xs[0][2], xs[0][3]); xw.z = cvt_pk_bf16(xs[1][0], xs[1][1]); xw.w = cvt_pk_bf16(xs[1][2], xs[1][3]); *(u32x4*)(X16 + t * D + col) = xw; }
                    u32x4 hw; hw.x = cvt_pk_bf16(h2[0], h2[1]); hw.y = cvt_pk_bf16(h2[2], h2[3]); hw.z = cvt_pk_bf16(h2[4], h2[5]); hw.w = cvt_pk_bf16(h2[6], h2[7]);
                    *(u32x4*)(H + t * D + col) = hw;
                    *(LAS u32x4*)(lds + OFF_HL + tl * HL_P + col * 2) = hw;
                    u32x4 lw; lw.x = cvt_pk_bf16(h2[0] - bf_lo(hw.x), h2[1] - bf_hi(hw.x)); lw.y = cvt_pk_bf16(h2[2] - bf_lo(hw.y), h2[3] - bf_hi(hw.y)); lw.z = cvt_pk_bf16(h2[4] - bf_lo(hw.z), h2[5] - bf_hi(hw.z)); lw.w = cvt_pk_bf16(h2[6] - bf_lo(hw.w), h2[7] - bf_hi(hw.w));
                    *(LAS u32x4*)(lds + OFF_HL2 + tl * HL_P + col * 2) = lw;
                }
            }
            __syncthreads();
            {
                f32x4 a0 = (f32x4){0.f, 0.f, 0.f, 0.f}, a1 = a0;
#pragma unroll
                for (int ks = 0; ks < 4; ++ks) {
                    const int k0 = 128 * w + 32 * ks + 8 * fq;
                    const bf16x8 hf_ = *(const LAS bf16x8*)(lds + OFF_HL + fr * HL_P + k0 * 2), hl_ = *(const LAS bf16x8*)(lds + OFF_HL2 + fr * HL_P + k0 * 2);
                    a0 = MFMA16(rl0[ks], hf_, a0); a1 = MFMA16(rl1[ks], hf_, a1); a0 = MFMA16(rw0[ks], hl_, a0); a1 = MFMA16(rw1[ks], hl_, a1); a0 = MFMA16(rw0[ks], hf_, a0); a1 = MFMA16(rw1[ks], hf_, a1);
                }
                *(LAS f32x4*)(LG + (w * 16 + fr) * 32 + 4 * fq) = a0; *(LAS f32x4*)(LG + (w * 16 + fr) * 32 + 16 + 4 * fq) = a1;
            }
            __syncthreads();
            {
                const int tk = tid >> 5, e = tid & 31; float s = brt_e;
#pragma unroll
                for (int ww = 0; ww < 8; ++ww) s += LG[(ww * 16 + tk) * 32 + e];
                LGT[(16 * st + tk) * 33 + e] = s;
            }
#pragma unroll
            for (int q = 0; q < 2; ++q)
#pragma unroll
                for (int hf = 0; hf < 2; ++hf) { cxr[q][hf] = nxr[q][hf]; cmr[q][hf] = nmr[q][hf]; }
        }
#undef LN1_LOAD2
        __syncthreads();
        if (tid < 256) {
            LAS float* row = LGT + tid * 33;
            float bv[4]; int bi[4];
#pragma unroll
            for (int k = 0; k < 4; ++k) {
                float best = -3.0e38f; int be = 0;
#pragma unroll 8
                for (int e = 0; e < 32; ++e) { const float vv = row[e]; if (vv > best) { best = vv; be = e; } }
                bv[k] = best; bi[k] = be; row[be] = -3.0e38f;
            }
            const float e1 = __expf(bv[1] - bv[0]), e2 = __expf(bv[2] - bv[0]), e3 = __expf(bv[3] - bv[0]); const float inv = 1.0f / (1.0f + e1 + e2 + e3);
            const float ww[4] = {inv, e1 * inv, e2 * inv, e3 * inv};
#pragma unroll
            for (int k = 0; k < 4; ++k) { const int a = tid * 4 + k; AE[a] = bi[k]; AW[a] = ww[k]; AR[a] = __hip_atomic_fetch_add(HIST + bi[k], 1, __ATOMIC_RELAXED, __HIP_MEMORY_SCOPE_WORKGROUP); }
        }
        __syncthreads();
        { const int t2 = opaque_tid(w); if (t2 < 32) BASE[t2] = (int)__hip_atomic_fetch_add(cntg + t2, (unsigned)HIST[t2], __ATOMIC_RELAXED, __HIP_MEMORY_SCOPE_AGENT); }
        __syncthreads();
#pragma unroll
        for (int q = 0; q < 2; ++q) {
            const int a = tid + 512 * q, e = AE[a], pos = BASE[e] + AR[a], tok = tb0 + (a >> 2);
            toklist[e * 65536 + pos] = tok; wlist[e * 65536 + pos] = AW[a]; topi[(size_t)tok * 4 + (a & 3)] = ((unsigned)e << 16) | (unsigned)pos;
        }
        __syncthreads();
    }
}

__device__ __forceinline__ void phase_ln2(const Ctx& X, int layer) {
    const bf16_t* OUT = (const bf16_t*)(X.ws + WS_R + R_OUT);
    bf16_t* H = (bf16_t*)(X.ws + WS_H);
    const float* ada = (const float*)(X.ws + WS_ADA) + (size_t)layer * NB * 6 * D;
    const float* adan = ada + (size_t)NB * 6 * D;
    const unsigned* topi = (const unsigned*)(X.ws + WS_TOPI);
    const LAS int* tb = (const LAS int*)(X.lds + LDS_TB); bf16_t* X16 = (bf16_t*)(X.ws + WS_X16);
    LAS float* CST = (LAS float*)X.lds;
    const bool last = (layer == NL - 1);
    for (int blk = X.bx; blk < T / 256; blk += X.G) {
        const int tid = opaque_tid(X.wid), lane = tid & 63, w = X.wid;
        const int tb0 = blk * 256, b = tb0 >> 11;
        __syncthreads();
        for (int i = tid; i < 5 * D; i += 512) { const int v = i >> 10, col = i & 1023; float val;
            if (v == 0) val = 1.0f + ada[(size_t)b * 6 * D + 5 * D + col]; else if (v == 1) val = last ? 1.0f : 1.0f + adan[(size_t)b * 6 * D + D + col]; else if (v == 2) val = last ? 0.f : adan[(size_t)b * 6 * D + col];
            else if (v == 3) val = X.ln2_g()[layer * D + col]; else val = X.ln2_b()[layer * D + col];
            CST[i] = val; }
        __syncthreads();
        {
            const size_t tw = (size_t)(tb0 + 32 * w);
            u32x4 oa[8], ob[8]; f32x4 xa[4], xb[4];
            f32x4 cg[4], clg[4], clb[4], csc[4], csh[4];
#pragma unroll
            for (int hf = 0; hf < 2; ++hf)
#pragma unroll
                for (int q4 = 0; q4 < 2; ++q4) { const int col = 512 * hf + 8 * lane + 4 * q4; cg[2 * hf + q4] = *(const LAS f32x4*)(CST + col); csc[2 * hf + q4] = *(const LAS f32x4*)(CST + D + col); csh[2 * hf + q4] = *(const LAS f32x4*)(CST + 2 * D + col);
                    clg[2 * hf + q4] = *(const LAS f32x4*)(CST + 3 * D + col); clb[2 * hf + q4] = *(const LAS f32x4*)(CST + 4 * D + col); }
#define LN2_LOAD(oo, xx, ti_, tt) do { const size_t _t = (tt); const unsigned _tv[4] = {ti_.x, ti_.y, ti_.z, ti_.w}; \
            _Pragma("unroll") for (int k = 0; k < 4; ++k) { const size_t _row = (size_t)(tb[32 + (int)(_tv[k] >> 16)] + (int)(_tv[k] & 0xffffu)); \
                oo[2 * k] = __builtin_nontemporal_load((const u32x4*)(OUT + _row * D + 8 * lane)); oo[2 * k + 1] = __builtin_nontemporal_load((const u32x4*)(OUT + _row * D + 512 + 8 * lane)); } \
            _Pragma("unroll") for (int hf = 0; hf < 2; ++hf) { const u32x4 _xw = __builtin_nontemporal_load((const u32x4*)(X16 + _t * D + 512 * hf + 8 * lane)); xx[2 * hf] = (f32x4){bf_lo(_xw.x), bf_hi(_xw.x), bf_lo(_xw.y), bf_hi(_xw.y)}; xx[2 * hf + 1] = (f32x4){bf_lo(_xw.z), bf_hi(_xw.z), bf_lo(_xw.w), bf_hi(_xw.w)}; } } while (0)
            u32x4 tiB = *(const u32x4*)(topi + tw * 4);
            LN2_LOAD(oa, xa, tiB, tw);
            tiB = *(const u32x4*)(topi + (tw + 1) * 4);
#pragma nounroll
            for (int q = 0; q < 32; ++q) {
                const size_t t = tw + q;
                const u32x4 tiC = *(const u32x4*)(topi + (tw + (q + 2 < 32 ? q + 2 : 31)) * 4);
                { const size_t tn = tw + (q + 1 < 32 ? q + 1 : 31); LN2_LOAD(ob, xb, tiB, tn); }
                float y[16];
#pragma unroll
                for (int j = 0; j < 16; ++j) y[j] = 0.f;
#pragma unroll
                for (int k = 0; k < 4; ++k)
#pragma unroll
                    for (int hf = 0; hf < 2; ++hf) { const u32x4 ow = oa[2 * k + hf];
                        y[8 * hf] += bf_lo(ow.x); y[8 * hf + 1] += bf_hi(ow.x); y[8 * hf + 2] += bf_lo(ow.y); y[8 * hf + 3] += bf_hi(ow.y);
                        y[8 * hf + 4] += bf_lo(ow.z); y[8 * hf + 5] += bf_hi(ow.z); y[8 * hf + 6] += bf_lo(ow.w); y[8 * hf + 7] += bf_hi(ow.w); }
                float v[16];
#pragma unroll
                for (int hf = 0; hf < 2; ++hf) { const int col = 512 * hf + 8 * lane;
                    const f32x4 x0 = xa[2 * hf], x1 = xa[2 * hf + 1];
                    const f32x4 g0 = cg[2 * hf], g1 = cg[2 * hf + 1];
#pragma unroll
                    for (int j = 0; j < 4; ++j) { v[8 * hf + j] = DN_ALPHA * x0[j] + g0[j] * y[8 * hf + j]; v[8 * hf + 4 + j] = DN_ALPHA * x1[j] + g1[j] * y[8 * hf + 4 + j]; } }
                float s = 0.f;
#pragma unroll
                for (int j = 0; j < 16; ++j) s += v[j];
                const float mu = wave_sum(s) * (1.0f / 1024.0f); float sq = 0.f;
#pragma unroll
                for (int j = 0; j < 16; ++j) { const float d = v[j] - mu; sq += d * d; }
                const float rstd = rsqrtf(wave_sum(sq) * (1.0f / 1024.0f) + LN_EPS);
#pragma unroll
                for (int hf = 0; hf < 2; ++hf) { const int col = 512 * hf + 8 * lane; float h[8]; f32x4 xs[2];
#pragma unroll
                    for (int q4 = 0; q4 < 2; ++q4) {
                        const f32x4 lg4 = clg[2 * hf + q4], lb4 = clb[2 * hf + q4], sc4 = csc[2 * hf + q4], sh4 = csh[2 * hf + q4];
                        f32x4 xo;
#pragma unroll
                        for (int j = 0; j < 4; ++j) { xo[j] = (v[8 * hf + 4 * q4 + j] - mu) * rstd * lg4[j] + lb4[j]; h[4 * q4 + j] = xo[j] * sc4[j] + sh4[j]; }
                        if (last) *(f32x4*)(X.out + t * D + col + 4 * q4) = xo;
                        xs[q4] = xo;
                    }
                    if (!last) { u32x4 xw; xw.x = cvt_pk_bf16(xs[0][0], xs[0][1]); xw.y = cvt_pk_bf16(xs[0][2], xs[0][3]); xw.z = cvt_pk_bf16(xs[1][0], xs[1][1]); xw.w = cvt_pk_bf16(xs[1][2], xs[1][3]); *(u32x4*)(X16 + t * D + col) = xw; }
                    if (!last) { u32x4 hw; hw.x = cvt_pk_bf16(h[0], h[1]); hw.y = cvt_pk_bf16(h[2], h[3]); hw.z = cvt_pk_bf16(h[4], h[5]); hw.w = cvt_pk_bf16(h[6], h[7]);
                        *(u32x4*)(H + t * D + col) = hw; } }
#pragma unroll
                for (int i = 0; i < 8; ++i) oa[i] = ob[i];
#pragma unroll
                for (int i = 0; i < 4; ++i) xa[i] = xb[i];
                tiB = tiC;
            }
#undef LN2_LOAD
        }
    }
    __syncthreads();
    if (!last) convert_layer_weights(X, layer + 1);
}

constexpr int PH_PER_LAYER = 9, N_PHASES = 2 + NL * PH_PER_LAYER;

__global__ void __launch_bounds__(512, 2) mega_fwd(Args args) {
    extern __shared__ __attribute__((aligned(16))) unsigned char lds_raw[];
    Ctx X;
    X.ka = (KArgsPtr)__builtin_amdgcn_kernarg_segment_ptr();
    X.out = args.out; X.ws = args.ws; X.lds = (LAS unsigned char*)lds_raw;
    X.wid = __builtin_amdgcn_readfirstlane((int)threadIdx.x >> 6); X.tid = opaque_tid(X.wid); X.lane = X.tid & 63; X.G = gridDim.x; X.bx = blockIdx.x;

    if (X.tid < 16) ((LAS unsigned*)(X.lds + LDS_XB))[X.tid] = 0u;
    __syncthreads();
    const int lo = args.ph_lo, hi = args.ph_hi;
    XcdBarrier bar; bar.bar = (unsigned*)(X.ws + WS_CTRL); bar.x = 0; bar.st = (volatile LAS unsigned*)(X.lds + LDS_XB);
    if (hi - lo > 1) bar = xcd_barrier_post((unsigned*)(X.ws + WS_CTRL), (volatile LAS unsigned*)(X.lds + LDS_XB), X.tid == 0);
#define IN(k) (lo <= (k) && (k) < hi)
#define SEAM(k) do { if (IN((k) + 1)) xcd_barrier(bar, opaque_tid(X.wid) == 0); } while (0)

    if (IN(0)) { refresh(X); phase_ada(X); SEAM(0); }
    if (IN(1)) { refresh(X); phase_h0(X); SEAM(1); }
    for (int l = 0; l < NL; ++l) {
        const int pb = 2 + l * PH_PER_LAYER;
        if (IN(pb + 0)) {
            refresh(X);
            ProbDense8<16> pr; pr.init(X, X.ws + WS_H, X.ws + WS_WB + WB_WIN, (bf16_t*)(X.ws + WS_R + R_P), INWP, INWP / 256, T / 256); pr.ncv = INW;
            gemm8_run<ProbDense8<16>, true>(X, pr); SEAM(pb + 0);
        }
        if (IN(pb + 1)) { refresh(X); phase_mixA(X, l); SEAM(pb + 1); }
        if (IN(pb + 2)) { refresh(X); phase_mixB(X, l); SEAM(pb + 2); }
        if (IN(pb + 3)) { refresh(X); ProbMG pr; pr.init(X, l); merge_run(X, pr); SEAM(pb + 3); }
        if (IN(pb + 4)) {
            refresh(X);
            ProbDense8<16> pr; pr.init(X, X.ws + WS_R + R_MG, X.ws + WS_WB + WB_WOUT, (bf16_t*)(X.ws + WS_R + R_MIX), D, D / 256, T / 256);
            gemm8_run<ProbDense8<16>, true>(X, pr); SEAM(pb + 4);
        }
        if (IN(pb + 5)) { refresh(X); phase_ln1(X, l); SEAM(pb + 5); }
        if (IN(pb + 6)) { refresh(X); moe_tables(X, l); ProbGU8 pr; pr.init(X, l); gemm8_run<ProbGU8, true>(X, pr); SEAM(pb + 6); }
        if (IN(pb + 7)) { refresh(X); moe_tables(X, l); ProbDN8 pr; pr.init(X, l); gemm8_run<ProbDN8, true>(X, pr); SEAM(pb + 7); }
        if (IN(pb + 8)) { refresh(X); moe_tables(X, l); phase_ln2(X, l); if (l < NL - 1) SEAM(pb + 8); }
    }
#undef IN
#undef SEAM
}

extern "C" void kernel_launch(void* const* d_in, const int* in_sizes, int n_in, void* d_out, int out_size, void* d_ws, size_t ws_size, hipStream_t stream) {
    static int grid = 0;
    if (grid == 0) {
        if (n_in != 25 || out_size != T * D || ws_size < WS_END) { fprintf(stderr, "kernel_launch: unexpected shapes (n_in %d, out %d, ws %zu < %zu); nothing launched\n", n_in, out_size, ws_size, (size_t)WS_END); grid = -1; return; }
        int dev = 0, cus = 0, per_cu = 0;
        if (hipGetDevice(&dev) != hipSuccess || hipDeviceGetAttribute(&cus, hipDeviceAttributeMultiprocessorCount, dev) != hipSuccess) { grid = -1; return; }
        if (hipFuncSetAttribute((const void*)mega_fwd, hipFuncAttributeMaxDynamicSharedMemorySize, LDS_BYTES) != hipSuccess) { fprintf(stderr, "kernel_launch: hipFuncSetAttribute failed\n"); grid = -1; return; }
        if (hipOccupancyMaxActiveBlocksPerMultiprocessor(&per_cu, (const void*)mega_fwd, 512, LDS_BYTES) != hipSuccess || per_cu < 1) { fprintf(stderr, "kernel_launch: occupancy query says %d blocks per CU\n", per_cu); per_cu = 1; }
        (void)hipGetLastError();
        grid = cus;
    }
    if (grid < 0) return;
    (void)hipMemsetAsync((char*)d_ws + WS_CTRL, 0, CTRL_BYTES, stream);
    Args a{};
    for (int i = 0; i < 25; ++i) a.in[i] = d_in[i];
    a.out = (float*)d_out; a.ws = (unsigned char*)d_ws;
#if MK_N_LAUNCHES == 1
    a.ph_lo = 0; a.ph_hi = N_PHASES;
    hipLaunchKernelGGL(mega_fwd, dim3(grid), dim3(512), LDS_BYTES, stream, a);
#else
    for (int p = 0; p < N_PHASES; ++p) { a.ph_lo = p; a.ph_hi = p + 1; hipLaunchKernelGGL(mega_fwd, dim3(grid), dim3(512), LDS_BYTES, stream, a); }
#endif
}
```

```cpp
#include <hip/hip_runtime.h>
#include <cstdio>
#include <cstdint>

#ifndef MK_N_LAUNCHES
#define MK_N_LAUNCHES 1
#endif

#define LAS __attribute__((address_space(3)))
typedef unsigned short bf16_t;
typedef short bf16x8 __attribute__((ext_vector_type(8)));
typedef float f32x4 __attribute__((ext_vector_type(4)));
typedef float f32x2 __attribute__((ext_vector_type(2)));
typedef unsigned u32x4 __attribute__((ext_vector_type(4)));
typedef unsigned u32x2 __attribute__((ext_vector_type(2)));

constexpr int D = 1024, NB = 32, SEQ = 2048, T = NB * SEQ, NL = 4;
constexpr int INW = 2432, INWP = 2560;
constexpr int NE = 32, DFF = 256, NASG = T * 4;
constexpr int CH = 128, NCH = SEQ / CH;
constexpr float DN_ALPHA = 1.681792830507429f, LN_EPS = 1e-5f;
constexpr int PC_RQ = 0, PC_RK = 128, PC_RV = 256, PC_RG = 512, PC_GU = 768, PC_GV = 1024, PC_CB = 1280, PC_CC = 1536, PC_CX = 1792, PC_GC = 2048;

constexpr size_t WS_CTRL = 0, CTRL_BYTES = 65536;
constexpr size_t CTRL_CNT = 16384;
constexpr size_t CTRL_CVQ = 32768;
constexpr size_t WS_ADA = WS_CTRL + CTRL_BYTES;
constexpr size_t WS_KV = WS_ADA + (size_t)NL * NB * 6 * D * 4;
constexpr size_t WS_TOPI = WS_KV + (size_t)NB * NCH * 4 * 64 * 32 * 4;
constexpr size_t WS_TOKL = WS_TOPI + (size_t)T * 4 * 4;
constexpr size_t WS_WL = WS_TOKL + (size_t)NE * 65536 * 4;
constexpr size_t WS_WB = WS_WL + (size_t)NE * 65536 * 4;
constexpr size_t WB_WIN = 0;
constexpr size_t WB_WBR = WB_WIN + (size_t)INWP * D * 2;
constexpr size_t WB_WGT = WB_WBR + (size_t)3 * D * 256 * 2;
constexpr size_t WB_WOUT = WB_WGT + (size_t)3 * D * 128 * 2;
constexpr size_t WB_WGU = WB_WOUT + (size_t)D * D * 2;
constexpr size_t WB_WDN = WB_WGU + (size_t)NE * 512 * D * 2;
constexpr size_t WB_WRT = WB_WDN + (size_t)NE * D * 256 * 2;
constexpr size_t WB_WSP = WB_WRT + (size_t)NE * D * 2;
constexpr size_t WB_WRTL = WB_WSP + (size_t)4 * 128 * 128 * 2;
constexpr size_t WB_END = WB_WRTL + (size_t)NE * D * 2;
constexpr size_t WS_H = WS_WB + WB_END;
constexpr size_t WS_R = WS_H + (size_t)T * D * 2;
constexpr size_t R_P = 0;
constexpr size_t R_BR = R_P + (size_t)T * INWP * 2;
constexpr size_t R_MG = R_BR + (size_t)T * 768 * 2;
constexpr size_t R_END = R_MG + (size_t)T * D * 2;
constexpr size_t R_MIX = 0;
constexpr size_t R_HLO = (size_t)T * D * 2;
constexpr size_t R_OUT = 0;
static_assert((size_t)(NASG + 256) * D * 2 <= R_END, "OUT overlay (+256 dummy rows for masked stores)");
constexpr size_t WS_ACT = WS_R + R_END;
constexpr size_t WS_X16 = WS_ACT + (size_t)(NASG + 256) * DFF * 2;
constexpr size_t WS_END = WS_X16 + (size_t)T * D * 2;

constexpr int ST_BYTES = 49152;
constexpr int LDS_MAIN = 3 * ST_BYTES;
constexpr int LDS_TB = LDS_MAIN;
constexpr int LDS_IDS = LDS_TB + 1024;
constexpr int LDS_PRM = LDS_TB + 4096;
constexpr int LDS_XB = LDS_TB + 8192;
constexpr int LDS_BYTES = LDS_XB + 64;

#define XB_TMO      128
#define XB_XCNT(j)  (256  + 64 * (j))
#define XB_XSUB(j)  (1280 + 64 * (j))
#define XB_XGEN(j)  (2304 + 64 * (j))
#define XB_TOP      3328
#define XB_TOPGEN   3392
#define XCD_BAR_WORDS 3456
#define XB_SPIN_CAP (1u << 18)

__device__ __forceinline__ unsigned xb_ld(unsigned* p)              { return __hip_atomic_load(p, __ATOMIC_RELAXED, __HIP_MEMORY_SCOPE_AGENT); }
__device__ __forceinline__ unsigned xb_add(unsigned* p, unsigned v) { return __hip_atomic_fetch_add(p, v, __ATOMIC_RELAXED, __HIP_MEMORY_SCOPE_AGENT); }
__device__ __forceinline__ unsigned xb_xcc_id() { return (unsigned)__builtin_amdgcn_s_getreg((3 << 11) | 20) & 0xFu; }
#define XB_SPIN(cond, bar) do { unsigned _sp = 0; while (cond) { __builtin_amdgcn_s_sleep(1); \
    if ((++_sp & 255u) == 0u) { if (xb_ld(&(bar)[XB_TMO])) break; if (_sp > XB_SPIN_CAP) { atomicAdd(&(bar)[XB_TMO], 1u); break; } } } } while (0)

struct XcdBarrier { unsigned* bar; unsigned x; volatile LAS unsigned* st; };

__device__ __forceinline__ XcdBarrier xcd_barrier_post(unsigned* bar, volatile LAS unsigned* st, bool leader) {
    XcdBarrier b; b.bar = bar; b.x = xb_xcc_id(); b.st = st;
    if (leader) (void)xb_add(&bar[XB_XCNT(b.x)], 1u);
    return b;
}
__device__ __forceinline__ void xcd_barrier_complete(unsigned* bar, unsigned x, unsigned& nloc, unsigned& nx) {
    const unsigned G = gridDim.x * gridDim.y * gridDim.z;
    unsigned sum, cnt, mine, sp = 0u;
    for (;;) {
        sum = 0u; cnt = 0u; mine = 0u;
#pragma unroll
        for (unsigned j = 0; j < 16; ++j) { const unsigned c = xb_ld(&bar[XB_XCNT(j)]); sum += c; cnt += (c > 0u) ? 1u : 0u; mine = (j == x) ? c : mine; }
        if (sum == G) break;
        __builtin_amdgcn_s_sleep(1);
        if ((++sp & 255u) == 0u) { if (xb_ld(&bar[XB_TMO])) break; if (sp > XB_SPIN_CAP) { atomicAdd(&bar[XB_TMO], 1u); break; } }
    }
    nloc = mine > 0u ? mine : 1u; nx = cnt > 0u ? cnt : 1u;
}
__device__ __forceinline__ void xcd_barrier(const XcdBarrier& b, bool leader) {
    asm volatile("s_waitcnt vmcnt(0)" ::: "memory");
    __syncthreads();
    if (leader) {
        unsigned* bar = b.bar;
        __builtin_amdgcn_s_waitcnt(0);
        unsigned nloc = b.st[0], nx = b.st[1];
        if (nloc == 0u) { xcd_barrier_complete(bar, b.x, nloc, nx); b.st[0] = nloc; b.st[1] = nx; }
        const unsigned old = xb_add(&bar[XB_XSUB(b.x)], 1u);
        const unsigned gen = old / nloc;
        if (old + 1u == (gen + 1u) * nloc) {
            __builtin_amdgcn_fence(__ATOMIC_RELEASE, "agent");
            asm volatile("s_waitcnt vmcnt(0)" ::: "memory");
            const unsigned og = xb_add(&bar[XB_TOP], 1u);
            const unsigned tg = og / nx;
            if (og + 1u == (tg + 1u) * nx) xb_add(&bar[XB_TOPGEN], 1u);
            else XB_SPIN(xb_ld(&bar[XB_TOPGEN]) == tg, bar);
            __builtin_amdgcn_fence(__ATOMIC_ACQUIRE, "agent");
            xb_add(&bar[XB_XGEN(b.x)], 1u);
            asm volatile("s_waitcnt vmcnt(0)" ::: "memory");
        } else {
            XB_SPIN(xb_ld(&bar[XB_XGEN(b.x)]) == gen, bar);
            __builtin_amdgcn_fence(__ATOMIC_ACQUIRE, "agent");
            asm volatile("s_waitcnt vmcnt(0)" ::: "memory");
        }
    }
    __syncthreads();
}

typedef _Float16 h16x2 __attribute__((ext_vector_type(2)));
typedef _Float16 f16x8 __attribute__((ext_vector_type(8)));
__device__ __forceinline__ unsigned cvt_pk_bf16(float lo, float hi) { h16x2 v; v.x = (_Float16)lo; v.y = (_Float16)hi; return __builtin_bit_cast(unsigned, v); }
__device__ __forceinline__ float bf_lo(unsigned w) { return (float)__builtin_bit_cast(h16x2, w).x; }
__device__ __forceinline__ float bf_hi(unsigned w) { return (float)__builtin_bit_cast(h16x2, w).y; }
__device__ __forceinline__ float fsigmoid(float x) { return __builtin_amdgcn_rcpf(1.0f + __expf(-x)); }
__device__ __forceinline__ f32x4 sigmoid4(f32x4 x) {
    f32x4 e;
#pragma unroll
    for (int j = 0; j < 4; ++j) e[j] = 1.0f + __builtin_amdgcn_exp2f(fminf(fmaxf(x[j], -15.0f), 15.0f) * -1.4426950408889634f);
    const float ab = e[0] * e[1], cd = e[2] * e[3], r = __builtin_amdgcn_rcpf(ab * cd);
    const float rab = r * cd, rcd = r * ab;
    return (f32x4){rab * e[1], rab * e[0], rcd * e[3], rcd * e[2]};
}
__device__ __forceinline__ f32x4 sigmoid4_pre(f32x4 xs) {
    f32x4 e;
#pragma unroll
    for (int j = 0; j < 4; ++j) e[j] = 1.0f + __builtin_amdgcn_exp2f(__builtin_amdgcn_fmed3f(xs[j], -21.640425613334451f, 21.640425613334451f));
    const float ab = e[0] * e[1], cd = e[2] * e[3], r = __builtin_amdgcn_rcpf(ab * cd);
    const float rab = r * cd, rcd = r * ab;
    return (f32x4){rab * e[1], rab * e[0], rcd * e[3], rcd * e[2]};
}
typedef _Float16 h2_t __attribute__((ext_vector_type(2)));
__device__ __forceinline__ unsigned pk_fma_h2(unsigned a, unsigned b, unsigned c) { return __builtin_bit_cast(unsigned, __builtin_elementwise_fma(__builtin_bit_cast(h2_t, a), __builtin_bit_cast(h2_t, b), __builtin_bit_cast(h2_t, c))); }
__device__ __forceinline__ float gelu_tanh(float x) { const float u = 0.7978845608028654f * (x + 0.044715f * x * x * x); return x * fsigmoid(2.0f * u); }
#define DPP_ADD(v, ctrl, rm) (v) += __builtin_bit_cast(float, __builtin_amdgcn_update_dpp(0, __builtin_bit_cast(int, (v)), (ctrl), (rm), 0xf, false))
__device__ __forceinline__ float wave_sum(float v) {
    DPP_ADD(v, 0xB1, 0xf);
    DPP_ADD(v, 0x4E, 0xf);
    DPP_ADD(v, 0x141, 0xf);
    DPP_ADD(v, 0x140, 0xf);
    DPP_ADD(v, 0x142, 0xa);
    DPP_ADD(v, 0x143, 0xc);
    return __builtin_bit_cast(float, __builtin_amdgcn_readlane(__builtin_bit_cast(int, v), 63));
}
__device__ __forceinline__ int opaque_tid(int wid) { int l; asm volatile("v_mbcnt_lo_u32_b32 %0, -1, 0\n\tv_mbcnt_hi_u32_b32 %0, -1, %0" : "=v"(l)); return (wid << 6) | l; }
__device__ __forceinline__ const char* uni_ptr(const char* p) { const unsigned long long v = (unsigned long long)p; const unsigned lo = __builtin_amdgcn_readfirstlane((unsigned)v), hi = __builtin_amdgcn_readfirstlane((unsigned)(v >> 32)); return (const char*)(((unsigned long long)hi << 32) | lo); }
#define UNI(x) __builtin_amdgcn_readfirstlane(x)
#define GLDS16(gp, lp) __builtin_amdgcn_global_load_lds((const unsigned*)(gp), (LAS unsigned*)(lp), 16, 0, 0)
#define WAIT_V(n) asm volatile("s_waitcnt vmcnt(" #n ")" ::: "memory")
#define WAIT_L0() asm volatile("s_waitcnt lgkmcnt(0)" ::: "memory")
#define SBAR() __builtin_amdgcn_s_barrier()
#define MFMA16(a, b, c) __builtin_amdgcn_mfma_f32_16x16x32_f16(__builtin_bit_cast(f16x8, (a)), __builtin_bit_cast(f16x8, (b)), (c), 0, 0, 0)

__device__ __forceinline__ int lds_byte(int r, int c) { return r * 128 + ((((c >> 3) ^ (r >> 1)) & 7) << 4) + (c & 7) * 2; }
__device__ __forceinline__ void stage_rc(int b, int& R, int& C) { R = b >> 7; C = ((((b >> 4) ^ (R >> 1)) & 7)) * 8; }
__device__ __forceinline__ int perm32(int rho) { const int n = rho >> 4, i = rho & 15; return 8 * (i >> 2) + 4 * n + (i & 3); }

struct Args { const void* in[25]; float* out; unsigned char* ws; int ph_lo, ph_hi; };
typedef const __attribute__((address_space(4))) Args* KArgsPtr;
struct Ctx {
    KArgsPtr ka; float* out; unsigned char* ws;
    LAS unsigned char* lds;
    int tid, lane, wid, G, bx;
    __device__ __forceinline__ const float* x() const { return (const float*)ka->in[0]; }
    __device__ __forceinline__ const float* c() const { return (const float*)ka->in[1]; }
    __device__ __forceinline__ const int* pos() const { return (const int*)ka->in[2]; }
    __device__ __forceinline__ const float* w_ada() const { return (const float*)ka->in[3]; }
    __device__ __forceinline__ const float* b_ada() const { return (const float*)ka->in[4]; }
    __device__ __forceinline__ const float* w_in() const { return (const float*)ka->in[5]; }
    __device__ __forceinline__ const float* gln_g() const { return (const float*)ka->in[6]; }
    __device__ __forceinline__ const float* gln_b() const { return (const float*)ka->in[7]; }
    __device__ __forceinline__ const float* w_sp() const { return (const float*)ka->in[8]; }
    __device__ __forceinline__ const float* b_sp() const { return (const float*)ka->in[9]; }
    __device__ __forceinline__ const float* conv_w() const { return (const float*)ka->in[10]; }
    __device__ __forceinline__ const float* w_br() const { return (const float*)ka->in[11]; }
    __device__ __forceinline__ const float* w_gt() const { return (const float*)ka->in[12]; }
    __device__ __forceinline__ const float* b_gt() const { return (const float*)ka->in[13]; }
    __device__ __forceinline__ const float* w_out() const { return (const float*)ka->in[14]; }
    __device__ __forceinline__ const float* ln1_g() const { return (const float*)ka->in[15]; }
    __device__ __forceinline__ const float* ln1_b() const { return (const float*)ka->in[16]; }
    __device__ __forceinline__ const float* w_rt() const { return (const float*)ka->in[17]; }
    __device__ __forceinline__ const float* b_rt() const { return (const float*)ka->in[18]; }
    __device__ __forceinline__ const float* w_gu() const { return (const float*)ka->in[19]; }
    __device__ __forceinline__ const float* b_gu() const { return (const float*)ka->in[20]; }
    __device__ __forceinline__ const float* w_dn() const { return (const float*)ka->in[21]; }
    __device__ __forceinline__ const float* b_dn() const { return (const float*)ka->in[22]; }
    __device__ __forceinline__ const float* ln2_g() const { return (const float*)ka->in[23]; }
    __device__ __forceinline__ const float* ln2_b() const { return (const float*)ka->in[24]; }
};

__device__ __forceinline__ bool sched_unit(const Ctx& X, int r, int NU, int& u) {
    const int L = r * X.G + X.bx;
    if ((X.G & 7) == 0) { const int x = L & 7, off = L >> 3, q = (NU + 7) >> 3; u = x * q + off; return off < q && u < NU; }
    u = L; return u < NU;
}

__device__ __forceinline__ int last_round(const Ctx& X, int NU) {
    if ((X.G & 7) == 0) { const int q = (NU + 7) >> 3, per = X.G >> 3; return (q + per - 1) / per - 1; }
    return (NU + X.G - 1) / X.G - 1;
}
constexpr int CVT_EARLY_GU = 12, CVT_EARLY_DN = 4;

struct GUnit { const char* a; const char* a1; const char* b; unsigned va[2][2]; int r0, c0, e, valid, xi; };

template <class Prob>
__device__ __forceinline__ void gemm_run(const Ctx& X, Prob& pr) {
    LAS unsigned char* lds = X.lds;
    const int wid = X.wid, lane = X.lane;
    const int wr = wid >> 2, wc = wid & 3, fr = lane & 15, fq = lane >> 4;
    const int aoff = lds_byte(wr * 64 + fr, fq * 8), boff = lds_byte(wc * 32 + fr, fq * 8), aoff1 = aoff ^ 64, boff1 = boff ^ 64;
    const unsigned ldsw = (unsigned)wid * 1024u;
    const int NU = pr.nunits();
    int u;
    if (!sched_unit(X, 0, NU, u)) return;
    GUnit cur, nxt;
    pr.decode(u, cur); nxt = cur;
    f32x4 acc[2][4][2];
#pragma unroll
    for (int a = 0; a < 2; ++a)
#pragma unroll
        for (int m = 0; m < 4; ++m)
#pragma unroll
            for (int n = 0; n < 2; ++n) acc[a][m][n] = (f32x4){0.f, 0.f, 0.f, 0.f};
    pr.issue(lds, 0u, ldsw, cur, 0);
    pr.issue(lds, (unsigned)ST_BYTES, ldsw, cur, 1);
    int ui = 0; unsigned so = 0;
    for (;;) {
        int un; const bool has_next = sched_unit(X, ui + 1, NU, un);
        if (has_next) pr.decode(un, nxt);
#pragma nounroll
        for (int kt = 0; kt < Prob::NK; ++kt) {
            const bool more = (kt + 1 < Prob::NK) || has_next;
            if (more) WAIT_V(6); else WAIT_V(0);
            SBAR();
            if (kt == 0) pr.params_issue(ui & 1, cur);
            unsigned s2 = so + 2u * ST_BYTES; if (s2 >= 3u * ST_BYTES) s2 -= 3u * ST_BYTES;
            if (kt + 2 < Prob::NK) pr.issue(lds, s2, ldsw, cur, kt + 2);
            else if (has_next) pr.issue(lds, s2, ldsw, nxt, kt + 2 - Prob::NK);
            bf16x8 Bf[2][2], Aq0[2][2], Aq1[2][2];
#define GS_LDAQ(dst, q) do { _Pragma("unroll") for (int m = 0; m < 2; ++m) _Pragma("unroll") for (int k = 0; k < 2; ++k) dst[m][k] = *(const LAS bf16x8*)(lds + so + ((q) >> 1) * 16384 + (k ? aoff1 : aoff) + (2 * ((q) & 1) + m) * 2048); } while (0)
#define GS_MMAQ(src_, q) do { __builtin_amdgcn_s_setprio(1); _Pragma("unroll") for (int m = 0; m < 2; ++m) _Pragma("unroll") for (int n = 0; n < 2; ++n) _Pragma("unroll") for (int k = 0; k < 2; ++k) \
                acc[(q) >> 1][2 * ((q) & 1) + m][n] = MFMA16(Bf[n][k], src_[m][k], acc[(q) >> 1][2 * ((q) & 1) + m][n]); __builtin_amdgcn_s_setprio(0); } while (0)
#pragma unroll
            for (int n = 0; n < 2; ++n)
#pragma unroll
                for (int k = 0; k < 2; ++k) Bf[n][k] = *(const LAS bf16x8*)(lds + so + 32768 + (k ? boff1 : boff) + n * 2048);
            GS_LDAQ(Aq0, 0); __builtin_amdgcn_sched_barrier(0);
            GS_LDAQ(Aq1, 1); __builtin_amdgcn_sched_barrier(0);
            GS_MMAQ(Aq0, 0); __builtin_amdgcn_sched_barrier(0);
            GS_LDAQ(Aq0, 2); __builtin_amdgcn_sched_barrier(0);
            GS_MMAQ(Aq1, 1); __builtin_amdgcn_sched_barrier(0);
            GS_LDAQ(Aq1, 3); __builtin_amdgcn_sched_barrier(0);
            GS_MMAQ(Aq0, 2); __builtin_amdgcn_sched_barrier(0);
            GS_MMAQ(Aq1, 3); __builtin_amdgcn_sched_barrier(0);
#undef GS_LDAQ
#undef GS_MMAQ
            pr.after_step(acc, cur, kt, ui & 1);
            so += ST_BYTES; if (so >= 3u * ST_BYTES) so = 0;
        }
        if (!has_next) break;
        cur = nxt; ++ui;
    }
    WAIT_L0(); SBAR();
}

__device__ __forceinline__ void zero_acc4(f32x4 (&acc)[2][2][4]) {
#pragma unroll
    for (int a = 0; a < 2; ++a)
#pragma unroll
        for (int m = 0; m < 2; ++m)
#pragma unroll
            for (int n = 0; n < 4; ++n) acc[a][m][n] = (f32x4){0.f, 0.f, 0.f, 0.f};
}
__device__ __forceinline__ void zero_acc(f32x4 (&acc)[2][4][2]) {
#pragma unroll
    for (int a = 0; a < 2; ++a)
#pragma unroll
        for (int m = 0; m < 4; ++m)
#pragma unroll
            for (int n = 0; n < 2; ++n) acc[a][m][n] = (f32x4){0.f, 0.f, 0.f, 0.f};
}

template <class Prob>
__device__ __forceinline__ void merge_run(const Ctx& X, Prob& pr) {
    LAS unsigned char* lds = X.lds;
    const int wid = X.wid, lane = X.lane;
    const int wr4 = wid >> 1, wc2 = wid & 1, fr = lane & 15, fq = lane >> 4;
    const int aoff = lds_byte(wr4 * 32 + fr, fq * 8), boff = lds_byte(wc2 * 64 + fr, fq * 8), aoff1 = aoff ^ 64, boff1 = boff ^ 64;
    const unsigned ldsw = (unsigned)wid * 1024u;
    const int NU = pr.nunits();
    int u;
    if (!sched_unit(X, 0, NU, u)) return;
    GUnit cur, nxt;
    pr.decode(u, cur); nxt = cur;
    f32x4 acc[2][2][4];
    zero_acc4(acc);
    pr.issue(lds, 0u, ldsw, cur, 0);
    pr.issue(lds, (unsigned)ST_BYTES, ldsw, cur, 1);
    int ui = 0; unsigned so = 0;
    int pi = 0, pr0 = cur.r0, pc0 = cur.c0;
    for (;;) {
        int un; const bool has_next = sched_unit(X, ui + 1, NU, un);
        if (has_next) pr.decode(un, nxt);
#pragma nounroll
        for (int i = 0; i < 3; ++i) {
#pragma unroll
            for (int j = 0; j < 6; ++j) {
                const int kt = 6 * i + j;
                const bool more = (kt + 1 < Prob::NK) || has_next;
                if (more) WAIT_V(6); else WAIT_V(0);
                SBAR();
                if (j == 0 && i == 0) pr.params_issue(ui & 1, cur);
                unsigned s2 = so + 2u * ST_BYTES; if (s2 >= 3u * ST_BYTES) s2 -= 3u * ST_BYTES;
                if (kt + 2 < Prob::NK) pr.issue(lds, s2, ldsw, cur, kt + 2);
                else if (has_next) pr.issue(lds, s2, ldsw, nxt, kt + 2 - Prob::NK);
                bf16x8 Bf[4][2], Aq0[2], Aq1[2];
#define GS_LDAQ(dst, q) do { _Pragma("unroll") for (int k = 0; k < 2; ++k) dst[k] = *(const LAS bf16x8*)(lds + so + ((q) >> 1) * 16384 + (k ? aoff1 : aoff) + ((q) & 1) * 2048); } while (0)
#define GS_MMAQ(src_, q) do { __builtin_amdgcn_s_setprio(1); _Pragma("unroll") for (int n = 0; n < 4; ++n) _Pragma("unroll") for (int k = 0; k < 2; ++k) \
                acc[(q) >> 1][(q) & 1][n] = MFMA16(Bf[n][k], src_[k], acc[(q) >> 1][(q) & 1][n]); __builtin_amdgcn_s_setprio(0); } while (0)
#pragma unroll
                for (int n = 0; n < 4; ++n)
#pragma unroll
                    for (int k = 0; k < 2; ++k) Bf[n][k] = *(const LAS bf16x8*)(lds + so + 32768 + (k ? boff1 : boff) + n * 2048);
                GS_LDAQ(Aq0, 0); __builtin_amdgcn_sched_barrier(0);
                GS_LDAQ(Aq1, 1); __builtin_amdgcn_sched_barrier(0);
                GS_MMAQ(Aq0, 0); __builtin_amdgcn_sched_barrier(0);
                GS_LDAQ(Aq0, 2); __builtin_amdgcn_sched_barrier(0);
                GS_MMAQ(Aq1, 1); __builtin_amdgcn_sched_barrier(0);
                GS_LDAQ(Aq1, 3); __builtin_amdgcn_sched_barrier(0);
                GS_MMAQ(Aq0, 2); __builtin_amdgcn_sched_barrier(0);
                GS_MMAQ(Aq1, 3); __builtin_amdgcn_sched_barrier(0);
#undef GS_LDAQ
#undef GS_MMAQ
                if (j == 0) pr.template chunk<0>(pi, pr0, pc0); else if (j == 1) pr.template chunk<1>(pi, pr0, pc0); else if (j == 2) pr.template chunk<2>(pi, pr0, pc0); else if (j == 3) pr.template chunk<3>(pi, pr0, pc0);
                __builtin_amdgcn_sched_barrier(0);
                if (j == 3) pr.park_y(acc);
                if (j == 5) { pr.park_h(acc, i, ui & 1); pi = i; pr0 = cur.r0; pc0 = cur.c0; }
                so += ST_BYTES; if (so >= 3u * ST_BYTES) so = 0;
            }
        }
        if (!has_next) break;
        cur = nxt; ++ui;
    }
    pr.template chunk<0>(pi, pr0, pc0); pr.template chunk<1>(pi, pr0, pc0); pr.template chunk<2>(pi, pr0, pc0); pr.template chunk<3>(pi, pr0, pc0);
    WAIT_L0(); SBAR();
}

struct LaneGeo { int wr, wc, fr, fq; int R[2], C[2], Rb[2]; };
__device__ __forceinline__ LaneGeo lane_geo(const Ctx& X) {
    LaneGeo g; g.wr = X.wid >> 2; g.wc = X.wid & 3; g.fr = X.lane & 15; g.fq = X.lane >> 4;
#pragma unroll
    for (int i = 0; i < 2; ++i) { int R, C; stage_rc(X.tid * 16 + i * 8192, R, C); g.R[i] = R; g.C[i] = C; g.Rb[i] = (R & ~31) + perm32(R & 31); }
    return g;
}
__device__ __forceinline__ void issue_std(LAS unsigned char* lds, unsigned so, unsigned ldsw, const char* a0, const char* a1, const unsigned (&va0)[2], const unsigned (&va1)[2], const char* b, const unsigned (&vb)[2]) {
    a0 = uni_ptr(a0); a1 = uni_ptr(a1); b = uni_ptr(b);
#pragma unroll
    for (int i = 0; i < 2; ++i) GLDS16(a0 + va0[i], lds + so + ldsw + i * 8192);
#pragma unroll
    for (int i = 0; i < 2; ++i) GLDS16(a1 + va1[i], lds + so + 16384 + ldsw + i * 8192);
#pragma unroll
    for (int i = 0; i < 2; ++i) GLDS16(b + vb[i], lds + so + 32768 + ldsw + i * 8192);
}
__device__ __forceinline__ void refresh(Ctx& X) { KArgsPtr k = X.ka; asm volatile("" : "+s"(k)); X.ka = k; const int t = opaque_tid(X.wid); X.tid = t; X.lane = t & 63; }

__device__ __forceinline__ unsigned char* wgu_buf(const Ctx& X, int l) { return (l & 1) ? (unsigned char*)X.out : X.ws + WS_WB + WB_WGU; }
__device__ __forceinline__ unsigned char* wdn_buf(const Ctx& X, int l) { return (l & 1) ? (unsigned char*)X.out + (size_t)NE * 512 * D * 2 : X.ws + WS_WB + WB_WDN; }
__device__ __forceinline__ void moe_tables(const Ctx& X, int layer) {
    LAS int* tb = (LAS int*)(X.lds + LDS_TB);
    if (X.tid < 32) {
        const unsigned* cnt = (const unsigned*)(X.ws + WS_CTRL + CTRL_CNT) + layer * 32;
        const int e = X.tid, c = (int)__hip_atomic_load(cnt + e, __ATOMIC_RELAXED, __HIP_MEMORY_SCOPE_AGENT), tl = (c + 255) >> 8;
        int so = c, st = tl;
#pragma unroll
        for (int o = 1; o < 32; o <<= 1) { const int a = __shfl_up(so, o, 32), b2 = __shfl_up(st, o, 32); if (e >= o) { so += a; st += b2; } }
        tb[e] = c; tb[32 + e] = so - c; tb[65 + e] = st - tl;
        if (e == 31) { tb[64] = so; tb[97] = st; }
    }
    __syncthreads();
}
__device__ __forceinline__ void moe_find(const LAS int* tb, int tile, int& e, int& j) {
    int l; asm volatile("v_mbcnt_lo_u32_b32 %0, -1, 0" : "=v"(l));
    const unsigned long long m = __ballot(tb[65 + l] <= tile);
    const int ee = __builtin_popcount((unsigned)m) - 1;
    e = ee; j = tile - tb[65 + ee];
}

struct G8Unit { const char* a0; const char* a1; const char* b0; const char* b1; int r0, c0, e, valid, xi; };
constexpr int HTB = 16384;

template <class Prob, bool SP2 = false>
__device__ __forceinline__ void gemm8_run(const Ctx& X, Prob& pr) {
    LAS unsigned char* lds = X.lds;
    const int wid = X.wid, lane = X.lane, wr = wid >> 2, wc = wid & 3, fr = lane & 15, fq = lane >> 4;
    constexpr int nt = Prob::NK;
    const int aoff = lds_byte(wr * 64 + fr, fq * 8), boff = lds_byte(wc * 32 + fr, fq * 8), aoff1 = aoff ^ 64, boff1 = boff ^ 64;
    const unsigned ldsw = (unsigned)wid * 1024u;
    const int NU = pr.nunits();
    int u;
    if (!sched_unit(X, 0, NU, u)) return;
    G8Unit cur, nxt;
    pr.decode(u, cur); nxt = cur;
    unsigned vaC[2][2], vaN[2][2];
    pr.first_va(cur, vaC);
#pragma unroll
    for (int h = 0; h < 2; ++h)
#pragma unroll
        for (int i = 0; i < 2; ++i) vaN[h][i] = vaC[h][i];
    const unsigned vb0 = pr.vb[0], vb1 = pr.vb[1];
    f32x4 acc[2][2][4][2];
#pragma unroll
    for (int a = 0; a < 2; ++a)
#pragma unroll
        for (int b = 0; b < 2; ++b)
#pragma unroll
            for (int m = 0; m < 4; ++m)
#pragma unroll
                for (int n = 0; n < 2; ++n) acc[a][b][m][n] = (f32x4){0.f, 0.f, 0.f, 0.f};
    bf16x8 At[4][2], B0[2][2], B1[2][2];
    constexpr unsigned kstep = 128u;
#define G8_SA(b, h) (((b) * 2 + (h)) * HTB)
#define G8_SB(b, h) ((4 + (b) * 2 + (h)) * HTB)
#define G8_STAGE(bufoff, gbase, v0, v1) do { const char* _sb = uni_ptr(gbase); GLDS16(_sb + (v0), lds + (bufoff) + ldsw); GLDS16(_sb + (v1), lds + (bufoff) + ldsw + 8192); } while (0)
#define G8_LDA(dst, b, h) do { _Pragma("unroll") for (int m = 0; m < 4; ++m) _Pragma("unroll") for (int k = 0; k < 2; ++k) dst[m][k] = *(const LAS bf16x8*)(lds + G8_SA(b, h) + (k ? aoff1 : aoff) + m * 2048); } while (0)
#define G8_LDB(dst, b, h) do { _Pragma("unroll") for (int n = 0; n < 2; ++n) _Pragma("unroll") for (int k = 0; k < 2; ++k) dst[n][k] = *(const LAS bf16x8*)(lds + G8_SB(b, h) + (k ? boff1 : boff) + n * 2048); } while (0)
#define G8_MMA(ai, bj, At_, Bt_) do { __builtin_amdgcn_s_setprio(1); _Pragma("unroll") for (int m = 0; m < 4; ++m) _Pragma("unroll") for (int n = 0; n < 2; ++n) _Pragma("unroll") for (int k = 0; k < 2; ++k) \
        acc[ai][bj][m][n] = MFMA16(Bt_[n][k], At_[m][k], acc[ai][bj][m][n]); __builtin_amdgcn_s_setprio(0); } while (0)
#define G8_WAIT_L(n) asm volatile("s_waitcnt lgkmcnt(" #n ")" ::: "memory")
#define G8_SCHED __builtin_amdgcn_sched_barrier(0)
    if constexpr (SP2) {
        G8_STAGE(G8_SB(0, 0), cur.b0, vb0, vb1); G8_STAGE(G8_SB(0, 1), cur.b1, vb0, vb1); G8_STAGE(G8_SA(0, 0), cur.a0, vaC[0][0], vaC[0][1]); G8_STAGE(G8_SA(0, 1), cur.a1, vaC[1][0], vaC[1][1]);
        if (wr == 1) SBAR();
        WAIT_V(2); SBAR();
    } else {
    G8_STAGE(G8_SB(0, 0), cur.b0, vb0, vb1); G8_STAGE(G8_SA(0, 0), cur.a0, vaC[0][0], vaC[0][1]); G8_STAGE(G8_SB(0, 1), cur.b1, vb0, vb1); G8_STAGE(G8_SA(0, 1), cur.a1, vaC[1][0], vaC[1][1]);
    if (wr == 1) SBAR();
    WAIT_V(4); SBAR();
    }
    G8_STAGE(G8_SB(1, 0), cur.b0 + kstep, vb0, vb1); G8_STAGE(G8_SA(1, 0), cur.a0 + kstep, vaC[0][0], vaC[0][1]); G8_STAGE(G8_SB(1, 1), cur.b1 + kstep, vb0, vb1);
    WAIT_V(6); SBAR();
    int ui = 0;
    for (;;) {
        int un; const bool has_next = sched_unit(X, ui + 1, NU, un);
        if (has_next) pr.decode(un, nxt);
        const char* nA0 = has_next ? nxt.a0 : cur.a0; const char* nA1 = has_next ? nxt.a1 : cur.a1; const char* nB0 = has_next ? nxt.b0 : cur.b0; const char* nB1 = has_next ? nxt.b1 : cur.b1;
#pragma nounroll
        for (int t = 0; t < nt; t += 2) {
            const bool last = (t == nt - 2);
            if (t == 0) pr.params_issue(ui & 1, cur);
            if constexpr (Prob::GATHER) {
                if (t == 0 && has_next) pr.ids_issue((ui + 1) & 1, nxt);
                if (last && has_next) pr.ids_read((ui + 1) & 1, vaN);
            }
            const char* a1h1 = cur.a1 + (unsigned)(t + 1) * kstep;
            const char* a2h0 = last ? nA0 : cur.a0 + (unsigned)(t + 2) * kstep; const char* a2h1 = last ? nA1 : cur.a1 + (unsigned)(t + 2) * kstep;
            const char* b2h0 = last ? nB0 : cur.b0 + (unsigned)(t + 2) * kstep; const char* b2h1 = last ? nB1 : cur.b1 + (unsigned)(t + 2) * kstep;
            unsigned v200 = vaC[0][0], v201 = vaC[0][1], v210 = vaC[1][0], v211 = vaC[1][1];
            if constexpr (Prob::GATHER) { if (last) { v200 = vaN[0][0]; v201 = vaN[0][1]; v210 = vaN[1][0]; v211 = vaN[1][1]; } }
            if constexpr (SP2) {
            G8_LDB(B0, 0, 0); G8_LDB(B1, 0, 1); G8_SCHED; G8_LDA(At, 0, 0); G8_STAGE(G8_SA(1, 1), a1h1, vaC[1][0], vaC[1][1]);
            WAIT_V(8); G8_WAIT_L(0); SBAR(); G8_MMA(0, 0, At, B0); G8_MMA(0, 1, At, B1); SBAR(); G8_SCHED;
            G8_LDA(At, 0, 1); G8_STAGE(G8_SB(0, 0), b2h0, vb0, vb1); G8_STAGE(G8_SB(0, 1), b2h1, vb0, vb1); G8_STAGE(G8_SA(0, 0), a2h0, v200, v201);
            WAIT_V(8); G8_WAIT_L(0); SBAR(); G8_MMA(1, 0, At, B0); G8_MMA(1, 1, At, B1); SBAR(); G8_SCHED;
            G8_LDB(B0, 1, 0); G8_LDB(B1, 1, 1); G8_SCHED; G8_LDA(At, 1, 0); G8_STAGE(G8_SA(0, 1), a2h1, v210, v211);
            WAIT_V(8); G8_WAIT_L(0); SBAR(); G8_MMA(0, 0, At, B0); G8_MMA(0, 1, At, B1); SBAR(); G8_SCHED;
            G8_LDA(At, 1, 1); G8_STAGE(G8_SB(1, 0), b2h0 + kstep, vb0, vb1); G8_STAGE(G8_SB(1, 1), b2h1 + kstep, vb0, vb1); G8_STAGE(G8_SA(1, 0), a2h0 + kstep, v200, v201);
            WAIT_V(8); G8_WAIT_L(0); SBAR(); G8_MMA(1, 0, At, B0); G8_MMA(1, 1, At, B1); SBAR(); G8_SCHED;
            } else {
            G8_LDB(B0, 0, 0); G8_SCHED; G8_LDA(At, 0, 0); G8_STAGE(G8_SA(1, 1), a1h1, vaC[1][0], vaC[1][1]);
            G8_WAIT_L(8); SBAR(); G8_WAIT_L(0); G8_MMA(0, 0, At, B0); SBAR(); G8_SCHED;
            G8_LDB(B1, 0, 1); G8_STAGE(G8_SB(0, 0), b2h0, vb0, vb1);
            SBAR(); G8_WAIT_L(0); G8_MMA(0, 1, At, B1); SBAR();
            G8_LDA(At, 0, 1); G8_STAGE(G8_SA(0, 0), a2h0, v200, v201);
            SBAR(); G8_WAIT_L(0); G8_MMA(1, 0, At, B0); SBAR(); G8_SCHED;
            G8_STAGE(G8_SB(0, 1), b2h1, vb0, vb1);
            WAIT_V(6); SBAR(); G8_MMA(1, 1, At, B1); SBAR();
            G8_LDB(B0, 1, 0); G8_SCHED; G8_LDA(At, 1, 0); G8_STAGE(G8_SA(0, 1), a2h1, v210, v211);
            G8_WAIT_L(8); SBAR(); G8_WAIT_L(0); G8_MMA(0, 0, At, B0); SBAR(); G8_SCHED;
            G8_LDB(B1, 1, 1); G8_STAGE(G8_SB(1, 0), b2h0 + kstep, vb0, vb1);
            SBAR(); G8_WAIT_L(0); G8_MMA(0, 1, At, B1); SBAR();
            G8_LDA(At, 1, 1); G8_STAGE(G8_SA(1, 0), a2h0 + kstep, v200, v201);
            SBAR(); G8_WAIT_L(0); G8_MMA(1, 0, At, B0); SBAR(); G8_SCHED;
            G8_STAGE(G8_SB(1, 1), b2h1 + kstep, vb0, vb1);
            WAIT_V(6); SBAR(); G8_MMA(1, 1, At, B1); SBAR();
            }
        }
        pr.epilogue(acc, cur, ui & 1);
        if (!has_next) break;
#pragma unroll
        for (int a = 0; a < 2; ++a)
#pragma unroll
            for (int b = 0; b < 2; ++b)
#pragma unroll
                for (int m = 0; m < 4; ++m)
#pragma unroll
                    for (int n = 0; n < 2; ++n) acc[a][b][m][n] = (f32x4){0.f, 0.f, 0.f, 0.f};
        cur = nxt; ++ui;
        if constexpr (Prob::GATHER) {
#pragma unroll
            for (int h = 0; h < 2; ++h)
#pragma unroll
                for (int i = 0; i < 2; ++i) vaC[h][i] = vaN[h][i];
        }
    }
    WAIT_V(0);
    if (wr == 0) SBAR();
    SBAR();
#undef G8_SA
#undef G8_SB
#undef G8_STAGE
#undef G8_LDA
#undef G8_LDB
#undef G8_MMA
#undef G8_WAIT_L
#undef G8_SCHED
}

__device__ __forceinline__ void store_tile8(const f32x4 (&acc)[2][2][4][2], bf16_t* O, int ldc, int r0, int c0, int wq, int nbj = 2) {
    const int t = opaque_tid(wq), wid = t >> 6, lane = t & 63, wr = wid >> 2, wc = wid & 3, fr = lane & 15, fq = lane >> 4;
#pragma unroll
    for (int ai = 0; ai < 2; ++ai)
#pragma unroll
        for (int m = 0; m < 4; ++m) {
            bf16_t* p = O + (size_t)(r0 + 128 * ai + 64 * wr + 16 * m + fr) * ldc + c0 + 32 * wc + 8 * fq;
#pragma unroll
            for (int bj = 0; bj < 2; ++bj) if (bj < nbj) { const f32x4 v0 = acc[ai][bj][m][0], v1 = acc[ai][bj][m][1];
                u32x4 w; w.x = cvt_pk_bf16(v0[0], v0[1]); w.y = cvt_pk_bf16(v0[2], v0[3]); w.z = cvt_pk_bf16(v1[0], v1[1]); w.w = cvt_pk_bf16(v1[2], v1[3]);
                *(u32x4*)(p + 128 * bj) = w; }
        }
}

template <int NK_> struct ProbDense8 {
    static constexpr int NK = NK_; static constexpr bool GATHER = false;
    const char* A; const char* B; bf16_t* O; int K, ldc, ncol, nu; unsigned va0[2], vb[2]; int wq; int ncv;
    __device__ __forceinline__ void init(const Ctx& X, const void* A_, const void* B_, bf16_t* O_, int ldc_, int ncol_, int nrow_) {
        ncv = ldc_; wq = X.wid; A = (const char*)A_; B = (const char*)B_; O = O_; K = NK_ * 64; ldc = ldc_; ncol = ncol_; nu = ncol_ * nrow_; const LaneGeo lg = lane_geo(X);
#pragma unroll
        for (int i = 0; i < 2; ++i) { va0[i] = (unsigned)(lg.R[i] * K + lg.C[i]) * 2u; vb[i] = (unsigned)(lg.Rb[i] * K + lg.C[i]) * 2u; }
    }
    __device__ __forceinline__ int nunits() const { return nu; }
    __device__ __forceinline__ void decode(int u, G8Unit& g) const {
        const int gsz = 8 * ncol, gid = u / gsz, rr = u - gid * gsz, pm = gid * 8 + (rr & 7), pn = rr >> 3;
        g.a0 = uni_ptr(A + (size_t)pm * 256 * K * 2); g.a1 = g.a0 + (size_t)128 * K * 2; g.b0 = uni_ptr(B + (size_t)pn * 256 * K * 2); g.b1 = g.b0 + (size_t)128 * K * 2;
        g.r0 = pm * 256; g.c0 = pn * 256; g.e = 0; g.valid = 256; g.xi = 0;
    }
    __device__ __forceinline__ void first_va(const G8Unit&, unsigned (&va)[2][2]) const {
#pragma unroll
        for (int h = 0; h < 2; ++h)
#pragma unroll
            for (int i = 0; i < 2; ++i) va[h][i] = va0[i]; }
    __device__ __forceinline__ void params_issue(int, const G8Unit&) const {}
    __device__ __forceinline__ void epilogue(const f32x4 (&acc)[2][2][4][2], const G8Unit& g, int) const { store_tile8(acc, O, ldc, g.r0, g.c0, wq, (g.c0 + 128 < ncv) ? 2 : 1); }
};

struct ProbGU8 {
    static constexpr int NK = 16; static constexpr bool GATHER = true;
    const char* H; const char* W; bf16_t* ACT; const int* toklist; const float* bgu; const LAS int* tb; LAS unsigned char* lds; unsigned vb[2]; int wq;
    __device__ __forceinline__ void init(const Ctx& X, int layer) {
        wq = X.wid;
        H = (const char*)(X.ws + WS_H); W = (const char*)wgu_buf(X, layer); ACT = (bf16_t*)(X.ws + WS_ACT); toklist = (const int*)(X.ws + WS_TOKL);
        bgu = X.b_gu() + (size_t)layer * NE * 512; tb = (const LAS int*)(X.lds + LDS_TB); lds = X.lds; const LaneGeo lg = lane_geo(X);
#pragma unroll
        for (int i = 0; i < 2; ++i) vb[i] = (unsigned)(lg.Rb[i] * 1024 + lg.C[i]) * 2u;
    }
    __device__ __forceinline__ int nunits() const { return tb[97] * 2; }
    __device__ __forceinline__ void decode(int u, G8Unit& g) const {
        const int tile = u >> 1, pn = u & 1; int e, j; moe_find(tb, tile, e, j); e = UNI(e); j = UNI(j);
        const int cnt = UNI(tb[e]), base = 256 * j;
        g.a0 = uni_ptr(H); g.a1 = g.a0; g.b0 = uni_ptr(W + (size_t)(e * 512 + 256 * pn) * 1024 * 2); g.b1 = g.b0 + (size_t)128 * 1024 * 2;
        g.r0 = UNI(tb[32 + e]) + base; g.c0 = pn; g.e = e; g.valid = cnt - base; g.xi = e * 65536 + base;
    }
    __device__ __forceinline__ void first_va(const G8Unit& g, unsigned (&va)[2][2]) const {
        const int t = opaque_tid(wq);
#pragma unroll
        for (int i = 0; i < 2; ++i) { int R, C; stage_rc(t * 16 + i * 8192, R, C);
#pragma unroll
            for (int h = 0; h < 2; ++h) { int pos = 128 * h + R; pos = pos < g.valid ? pos : g.valid - 1; const int tok = toklist[g.xi + pos]; va[h][i] = (unsigned)tok * 2048u + (unsigned)C * 2u; } }
    }
    __device__ __forceinline__ void ids_issue(int par, const G8Unit& n) const {
        const int t = opaque_tid(wq);
        if (t < 256) { int pos = t < n.valid ? t : n.valid - 1; __builtin_amdgcn_global_load_lds((const unsigned*)(toklist + n.xi + pos), (LAS unsigned*)(lds + LDS_IDS + par * 1024 + (t >> 6) * 256), 4, 0, 0); }
    }
    __device__ __forceinline__ void ids_read(int par, unsigned (&va)[2][2]) const {
        const LAS int* ids = (const LAS int*)(lds + LDS_IDS + par * 1024); const int t = opaque_tid(wq);
#pragma unroll
        for (int i = 0; i < 2; ++i) { int R, C; stage_rc(t * 16 + i * 8192, R, C);
#pragma unroll
            for (int h = 0; h < 2; ++h) va[h][i] = (unsigned)ids[128 * h + R] * 2048u + (unsigned)C * 2u; }
    }
    __device__ __forceinline__ void params_issue(int par, const G8Unit& g) const {
        const int t = opaque_tid(wq);
        if (t < 256) __builtin_amdgcn_global_load_lds((const unsigned*)(bgu + g.e * 512 + (t < 128 ? 0 : 128) + 128 * g.c0 + t), (LAS unsigned*)(lds + LDS_PRM + par * 2048 + (t >> 6) * 256), 4, 0, 0);
    }
    __device__ __forceinline__ void epilogue(const f32x4 (&acc)[2][2][4][2], const G8Unit& g, int par) const {
        const int t = opaque_tid(wq), wid = t >> 6, lane = t & 63, wr = wid >> 2, wc = wid & 3, fr = lane & 15, fq = lane >> 4;
        const int actcol = 128 * g.c0 + 32 * wc + 8 * fq;
        const LAS float* bp = (const LAS float*)(lds + LDS_PRM + par * 2048) + 32 * wc + 8 * fq;
        const f32x4 bg0 = *(const LAS f32x4*)bp, bg1 = *(const LAS f32x4*)(bp + 4), bu0 = *(const LAS f32x4*)(bp + 128), bu1 = *(const LAS f32x4*)(bp + 132);
#pragma unroll
        for (int ai = 0; ai < 2; ++ai)
#pragma unroll
            for (int m = 0; m < 4; ++m) {
                const int rloc = 128 * ai + 64 * wr + 16 * m + fr;
                {
                    const size_t orow = rloc < g.valid ? (size_t)(g.r0 + rloc) : (size_t)(NASG + rloc);
                    float o[8];
#pragma unroll
                    for (int n = 0; n < 2; ++n) { const f32x4 gt = acc[ai][0][m][n] + (n ? bg1 : bg0), up = acc[ai][1][m][n] + (n ? bu1 : bu0);
#pragma unroll
                        for (int q = 0; q < 4; ++q) { const float gq = fminf(gt[q], 7.0f), uq = fminf(fmaxf(up[q], -7.0f), 7.0f); o[4 * n + q] = (uq + 1.0f) * (gq * fsigmoid(1.702f * gq)); } }
                    u32x4 w; w.x = cvt_pk_bf16(o[0], o[1]); w.y = cvt_pk_bf16(o[2], o[3]); w.z = cvt_pk_bf16(o[4], o[5]); w.w = cvt_pk_bf16(o[6], o[7]);
                    *(u32x4*)(ACT + orow * 256 + actcol) = w;
                }
            }
    }
};

struct ProbDN8 {
    static constexpr int NK = 4; static constexpr bool GATHER = false;
    const char* ACT; const char* W; bf16_t* OUT; const float* wlist; const float* bdn; const LAS int* tb; LAS unsigned char* lds; unsigned va0[2], vb[2]; int wq;
    __device__ __forceinline__ void init(const Ctx& X, int layer) {
        wq = X.wid; lds = X.lds;
        ACT = (const char*)(X.ws + WS_ACT); W = (const char*)wdn_buf(X, layer); OUT = (bf16_t*)(X.ws + WS_R + R_OUT); wlist = (const float*)(X.ws + WS_WL);
        bdn = X.b_dn() + (size_t)layer * NE * 1024; tb = (const LAS int*)(X.lds + LDS_TB); const LaneGeo lg = lane_geo(X);
#pragma unroll
        for (int i = 0; i < 2; ++i) { va0[i] = (unsigned)(lg.R[i] * 256 + lg.C[i]) * 2u; vb[i] = (unsigned)(lg.Rb[i] * 256 + lg.C[i]) * 2u; }
    }
    __device__ __forceinline__ int nunits() const { return tb[97] * 4; }
    __device__ __forceinline__ void decode(int u, G8Unit& g) const {
        const int tile = u >> 2, pn = u & 3; int e, j; moe_find(tb, tile, e, j); e = UNI(e); j = UNI(j);
        const int cnt = UNI(tb[e]), base = 256 * j, row0 = UNI(tb[32 + e]) + base;
        g.a0 = uni_ptr(ACT + (size_t)row0 * 512); g.a1 = g.a0 + (size_t)128 * 512; g.b0 = uni_ptr(W + (size_t)(e * 1024 + 256 * pn) * 256 * 2); g.b1 = g.b0 + (size_t)128 * 256 * 2;
        g.r0 = row0; g.c0 = 256 * pn; g.e = e; g.valid = cnt - base; g.xi = e * 65536 + base;
    }
    __device__ __forceinline__ void first_va(const G8Unit&, unsigned (&va)[2][2]) const {
#pragma unroll
        for (int h = 0; h < 2; ++h)
#pragma unroll
            for (int i = 0; i < 2; ++i) va[h][i] = va0[i]; }
    __device__ __forceinline__ void params_issue(int par, const G8Unit& g) const {
        const int t = opaque_tid(wq);
        if (t < 256) {
            __builtin_amdgcn_global_load_lds((const unsigned*)(bdn + g.e * 1024 + g.c0 + t), (LAS unsigned*)(lds + LDS_PRM + par * 2048 + (t >> 6) * 256), 4, 0, 0);
            __builtin_amdgcn_global_load_lds((const unsigned*)(wlist + g.xi + (t < g.valid ? t : g.valid - 1)), (LAS unsigned*)(lds + LDS_PRM + par * 2048 + 1024 + (t >> 6) * 256), 4, 0, 0);
        }
    }
    __device__ __forceinline__ void epilogue(const f32x4 (&acc)[2][2][4][2], const G8Unit& g, int par) const {
        const int t = opaque_tid(wq), wid = t >> 6, lane = t & 63, wr = wid >> 2, wc = wid & 3, fr = lane & 15, fq = lane >> 4;
        const int col = g.c0 + 32 * wc + 8 * fq;
        const LAS float* bp = (const LAS float*)(lds + LDS_PRM + par * 2048) + 32 * wc + 8 * fq; const LAS float* wp = (const LAS float*)(lds + LDS_PRM + par * 2048 + 1024);
        f32x4 bb[2][2];
#pragma unroll
        for (int bj = 0; bj < 2; ++bj) { bb[bj][0] = *(const LAS f32x4*)(bp + 128 * bj); bb[bj][1] = *(const LAS f32x4*)(bp + 128 * bj + 4); }
        float w8[2][4];
#pragma unroll
        for (int ai = 0; ai < 2; ++ai)
#pragma unroll
            for (int m = 0; m < 4; ++m) { const int rloc = 128 * ai + 64 * wr + 16 * m + fr; w8[ai][m] = wp[rloc]; }
#pragma unroll
        for (int ai = 0; ai < 2; ++ai)
#pragma unroll
            for (int m = 0; m < 4; ++m) {
                const int rloc = 128 * ai + 64 * wr + 16 * m + fr;
                {
                    const size_t orow = rloc < g.valid ? (size_t)(g.r0 + rloc) : (size_t)(NASG + rloc);
                    const float w = w8[ai][m];
#pragma unroll
                    for (int bj = 0; bj < 2; ++bj) { const f32x4 v0 = (acc[ai][bj][m][0] + bb[bj][0]) * w, v1 = (acc[ai][bj][m][1] + bb[bj][1]) * w;
                        u32x4 o; o.x = cvt_pk_bf16(v0[0], v0[1]); o.y = cvt_pk_bf16(v0[2], v0[3]); o.z = cvt_pk_bf16(v1[0], v1[1]); o.w = cvt_pk_bf16(v1[2], v1[3]);
                        *(u32x4*)(OUT + orow * 1024 + col + 128 * bj) = o; }
                }
            }
    }
};

struct ProbMG {
    static constexpr int NK = 18;
    const char* P; const char* BR; const char* WGT; const char* WBR; bf16_t* MG; const float* bgate;
    u32x2 gpk[2][2][4], hpk[2][2][4], mpk[2][2][4]; int wq; LAS unsigned char* ldsb;
    __device__ __forceinline__ void init(const Ctx& X, int layer) {
        wq = X.wid; ldsb = X.lds;
        P = (const char*)(X.ws + WS_R + R_P); BR = (const char*)(X.ws + WS_R + R_BR); WGT = (const char*)(X.ws + WS_WB + WB_WGT); WBR = (const char*)(X.ws + WS_WB + WB_WBR);
        MG = (bf16_t*)(X.ws + WS_R + R_MG); bgate = X.b_gt() + (size_t)layer * 3 * 1024;
#pragma unroll
        for (int a = 0; a < 2; ++a)
#pragma unroll
            for (int m = 0; m < 2; ++m)
#pragma unroll
                for (int n = 0; n < 4; ++n) { gpk[a][m][n] = (u32x2){0u, 0u}; hpk[a][m][n] = (u32x2){0u, 0u}; mpk[a][m][n] = (u32x2){0u, 0u}; }
    }
    __device__ __forceinline__ int nunits() const { return 256 * 8; }
    __device__ __forceinline__ void decode(int u, GUnit& g) const { g.a = nullptr; g.a1 = nullptr; g.b = nullptr; g.r0 = (u >> 3) * 256; g.c0 = (u & 7) * 128; g.e = 0; g.valid = 256; g.xi = 0;
#pragma unroll
        for (int h = 0; h < 2; ++h)
#pragma unroll
            for (int i = 0; i < 2; ++i) g.va[h][i] = 0; }
    __device__ __forceinline__ void issue(LAS unsigned char* lds, unsigned so, unsigned ldsw, const GUnit& g, int kt) const {
        const int i = kt / 6, j = kt - 6 * i; const bool gate = j >= 4; const int jj = gate ? j - 4 : j;
        const int lda = gate ? INWP : 768, ldb = gate ? 128 : 256;
        const char* a = gate ? P + ((size_t)g.r0 * INWP + PC_GC + 128 * i + 64 * jj) * 2 : BR + ((size_t)g.r0 * 768 + 256 * i + 64 * jj) * 2;
        const char* a1 = a + (size_t)128 * lda * 2;
        const char* b = gate ? WGT + ((size_t)(i * 1024 + g.c0) * 128 + 64 * jj) * 2 : WBR + ((size_t)(i * 1024 + g.c0) * 256 + 64 * jj) * 2;
        const int t = opaque_tid(wq);
        unsigned va[2], vb[2];
#pragma unroll
        for (int q = 0; q < 2; ++q) { int R, C; stage_rc(t * 16 + q * 8192, R, C); const int Rb = (R & ~31) + perm32(R & 31); va[q] = (unsigned)(R * lda + C) * 2u; vb[q] = (unsigned)(Rb * ldb + C) * 2u; }
        issue_std(lds, so, ldsw, a, a1, va, va, b, vb);
    }
    __device__ __forceinline__ void params_issue(int par, const GUnit& g) const {
        const int t = opaque_tid(wq);
        if (t < 384) __builtin_amdgcn_global_load_lds((const unsigned*)(bgate + (t >> 7) * 1024 + g.c0 + (t & 127)), (LAS unsigned*)(ldsb + LDS_PRM + par * 2048 + (t >> 6) * 256), 4, 0, 0);
    }
    __device__ __forceinline__ void park_y(f32x4 (&acc)[2][2][4]) {
#pragma unroll
        for (int ai = 0; ai < 2; ++ai)
#pragma unroll
            for (int m = 0; m < 2; ++m)
#pragma unroll
                for (int n = 0; n < 4; ++n) { const f32x4 v = acc[ai][m][n]; gpk[ai][m][n].x = cvt_pk_bf16(v[0], v[1]); gpk[ai][m][n].y = cvt_pk_bf16(v[2], v[3]); }
        zero_acc4(acc);
    }
    __device__ __forceinline__ void park_h(f32x4 (&acc)[2][2][4], int i, int par) {
        const int t = opaque_tid(wq), wid = t >> 6, lane = t & 63, wc2 = wid & 1, fq = lane >> 4;
        const LAS float* bp = (const LAS float*)(ldsb + LDS_PRM + par * 2048) + i * 128 + 64 * wc2 + 8 * fq;
        f32x4 bb[4];
#pragma unroll
        for (int n = 0; n < 4; ++n) bb[n] = *(const LAS f32x4*)(bp + 32 * (n >> 1) + 4 * (n & 1));
#pragma unroll
        for (int ai = 0; ai < 2; ++ai)
#pragma unroll
            for (int m = 0; m < 2; ++m)
#pragma unroll
                for (int n = 0; n < 4; ++n) { const f32x4 v = (acc[ai][m][n] + bb[n]) * -1.4426950408889634f; hpk[ai][m][n].x = cvt_pk_bf16(v[0], v[1]); hpk[ai][m][n].y = cvt_pk_bf16(v[2], v[3]); }
        zero_acc4(acc);
    }
    template <int C>
    __device__ __forceinline__ void chunk(int pi, int pr0, int pc0) {
        constexpr int ai = C >> 1, mm = C & 1;
        const int t = opaque_tid(wq), wid = t >> 6, lane = t & 63, wr4 = wid >> 1, wc2 = wid & 1, fr = lane & 15, fq = lane >> 4;
#pragma unroll
        for (int g = 0; g < 2; ++g) {
#pragma unroll
            for (int n2 = 0; n2 < 2; ++n2) {
                const int n = 2 * g + n2;
                const u32x2 hp = hpk[ai][mm][n];
                const f32x4 gv = sigmoid4_pre((f32x4){bf_lo(hp.x), bf_hi(hp.x), bf_lo(hp.y), bf_hi(hp.y)});
                const u32x2 yp = gpk[ai][mm][n]; const unsigned g0 = cvt_pk_bf16(gv[0], gv[1]), g1 = cvt_pk_bf16(gv[2], gv[3]);
                const u32x2 mp = (pi > 0) ? mpk[ai][mm][n] : (u32x2){0u, 0u};
                mpk[ai][mm][n].x = pk_fma_h2(g0, yp.x, mp.x); mpk[ai][mm][n].y = pk_fma_h2(g1, yp.y, mp.y);
            }
            if (pi == 2) { u32x4 w; w.x = mpk[ai][mm][2 * g].x; w.y = mpk[ai][mm][2 * g].y; w.z = mpk[ai][mm][2 * g + 1].x; w.w = mpk[ai][mm][2 * g + 1].y;
                *(u32x4*)(MG + (size_t)(pr0 + 128 * ai + 32 * wr4 + 16 * mm + fr) * 1024 + pc0 + 64 * wc2 + 32 * g + 8 * fq) = w; }
        }
    }
};

struct CvtTile { const float* src; bf16_t* dst; int ld, k0, n0, dstK, gu; };
__device__ __forceinline__ void cvt_load(const Ctx& X, const CvtTile& t, f32x4 (&v)[2]) {
    const int tid = X.tid, kk = tid >> 4, n4 = tid & 15;
#pragma unroll
    for (int h = 0; h < 2; ++h) v[h] = __builtin_nontemporal_load((const f32x4*)(t.src + (size_t)(t.k0 + kk + 32 * h) * t.ld + t.n0 + 4 * n4));
}
__device__ __forceinline__ void cvt_finish(const Ctx& X, const CvtTile& t, const f32x4 (&v)[2], int buf) {
    LAS float* Tl = (LAS float*)(X.lds + buf * (64 * 65 * 4));
    const int tid = X.tid;
    { const int kk = tid >> 4, n4 = tid & 15;
#pragma unroll
      for (int h = 0; h < 2; ++h) { LAS float* q = Tl + (kk + 32 * h) * 65 + 4 * n4; q[0] = v[h][0]; q[1] = v[h][1]; q[2] = v[h][2]; q[3] = v[h][3]; } }
    __syncthreads();
    { const int n = tid >> 3, kc = tid & 7; float w8[8];
#pragma unroll
      for (int j = 0; j < 8; ++j) w8[j] = Tl[(8 * kc + j) * 65 + n];
      int drow = t.n0 + n;
      if (t.gu) { const int nt = t.n0 >> 6, up = nt >> 2, cidx = 64 * (nt & 3) + n; drow = 256 * (cidx >> 7) + 128 * up + (cidx & 127); }
      u32x4 w; w.x = cvt_pk_bf16(w8[0], w8[1]); w.y = cvt_pk_bf16(w8[2], w8[3]); w.z = cvt_pk_bf16(w8[4], w8[5]); w.w = cvt_pk_bf16(w8[6], w8[7]);
      *(u32x4*)(t.dst + (size_t)drow * t.dstK + t.k0 + 8 * kc) = w; }
}

constexpr int CVT_N_IN = 16 * 38, CVT_N_BR = 3 * 64, CVT_N_GT = 3 * 32, CVT_N_OUT = 256, CVT_N_GU = 32 * 128, CVT_N_DN = 32 * 64;
constexpr int CVT_TILES = CVT_N_IN + CVT_N_BR + CVT_N_GT + CVT_N_OUT + CVT_N_GU + CVT_N_DN;
__device__ __forceinline__ void convert_tiles(const Ctx& X, int l, int id0, int step, int id1) {
    unsigned char* wb = X.ws + WS_WB;
    constexpr int N_IN = CVT_N_IN, N_BR = CVT_N_BR, N_GT = CVT_N_GT, N_OUT = CVT_N_OUT, N_GU = CVT_N_GU;
    constexpr int E0 = N_IN, E1 = E0 + N_BR, E2 = E1 + N_GT, E3 = E2 + N_OUT, E4 = E3 + N_GU;
    const int E5 = id1;
    auto decode = [&](int id, CvtTile& t) __attribute__((always_inline)) {
        if (id < E0) { const int kt = id / 38, nt = id - kt * 38; t.src = X.w_in() + (size_t)l * D * INW; t.ld = INW; t.k0 = 64 * kt; t.n0 = 64 * nt; t.dst = (bf16_t*)(wb + WB_WIN); t.dstK = D; t.gu = 0; }
        else if (id < E1) { const int q = id - E0, i = q >> 6, r = q & 63, kt = r >> 4, nt = r & 15; t.src = X.w_br() + (size_t)(l * 3 + i) * 256 * D; t.ld = D; t.k0 = 64 * kt; t.n0 = 64 * nt; t.dst = (bf16_t*)(wb + WB_WBR) + (size_t)i * D * 256; t.dstK = 256; t.gu = 0; }
        else if (id < E2) { const int q = id - E1, i = q >> 5, r = q & 31, kt = r >> 4, nt = r & 15; t.src = X.w_gt() + (size_t)(l * 3 + i) * 128 * D; t.ld = D; t.k0 = 64 * kt; t.n0 = 64 * nt; t.dst = (bf16_t*)(wb + WB_WGT) + (size_t)i * D * 128; t.dstK = 128; t.gu = 0; }
        else if (id < E3) { const int q = id - E2, kt = q >> 4, nt = q & 15; t.src = X.w_out() + (size_t)l * D * D; t.ld = D; t.k0 = 64 * kt; t.n0 = 64 * nt; t.dst = (bf16_t*)(wb + WB_WOUT); t.dstK = D; t.gu = 0; }
        else if (id < E4) { const int q = id - E3, e = q >> 7, r = q & 127, kt = r >> 3, nt = r & 7; t.src = X.w_gu() + (size_t)(l * NE + e) * D * 512; t.ld = 512; t.k0 = 64 * kt; t.n0 = 64 * nt; t.dst = (bf16_t*)wgu_buf(X, l) + (size_t)e * 512 * D; t.dstK = D; t.gu = 1; }
        else { const int q = id - E4, e = q >> 6, r = q & 63, kt = r >> 4, nt = r & 15; t.src = X.w_dn() + (size_t)(l * NE + e) * 256 * D; t.ld = D; t.k0 = 64 * kt; t.n0 = 64 * nt; t.dst = (bf16_t*)wdn_buf(X, l) + (size_t)e * D * 256; t.dstK = 256; t.gu = 0; }
    };
    {
        int id = id0; CvtTile tA{}, tB{}; f32x4 vA[2] = {}, vB[2] = {};
        if (id < E5) { decode(id, tA); cvt_load(X, tA, vA); }
        for (;;) {
            if (id >= E5) break;
            { const int idn = id + step; if (idn < E5) { decode(idn, tB); cvt_load(X, tB, vB); } cvt_finish(X, tA, vA, 0); id = idn; }
            if (id >= E5) break;
            { const int idn = id + step; if (idn < E5) { decode(idn, tA); cvt_load(X, tA, vA); } cvt_finish(X, tB, vB, 1); id = idn; }
        }
        __syncthreads();
    }
}
__device__ __forceinline__ void convert_early(const Ctx& X, int lnext, int n) {
    LAS int* slot = (LAS int*)(X.lds + 2 * 64 * 65 * 4);
    asm volatile("s_waitcnt vmcnt(0)" ::: "memory");
    __syncthreads();
    if (X.tid == 0) *slot = (int)__hip_atomic_fetch_add((unsigned*)(X.ws + WS_CTRL + CTRL_CVQ) + lnext * 64, (unsigned)n, __ATOMIC_RELAXED, __HIP_MEMORY_SCOPE_AGENT);
    __syncthreads();
    const int b = __builtin_amdgcn_readfirstlane(*slot);
    const int e = (b + n < CVT_TILES) ? b + n : CVT_TILES;
    if (b < e) convert_tiles(X, lnext, b, 1, e);
}
__device__ __forceinline__ void convert_layer_weights(const Ctx& X, int l, bool fresh) {
    unsigned char* wb = X.ws + WS_WB;
    int c0 = 0;
    if (!fresh) { c0 = (int)__hip_atomic_load((unsigned*)(X.ws + WS_CTRL + CTRL_CVQ) + l * 64, __ATOMIC_RELAXED, __HIP_MEMORY_SCOPE_AGENT); c0 = __builtin_amdgcn_readfirstlane(c0); if (c0 > CVT_TILES) c0 = CVT_TILES; }
    convert_tiles(X, l, c0 + X.bx, X.G, CVT_TILES);
    int gsz = X.G * 512; asm volatile("" : "+s"(gsz));
    const int gtid = X.bx * 512 + X.tid;
    { bf16_t* d = (bf16_t*)(wb + WB_WRT); const float* s = X.w_rt() + (size_t)l * D * NE;
      bf16_t* dl = (bf16_t*)(wb + WB_WRTL);
      for (int idx = gtid; idx < NE * D; idx += gsz) { const int e = idx >> 10, k = idx & 1023; const float v = s[k * NE + e]; const unsigned hi = cvt_pk_bf16(v, 0.f) & 0xffffu; d[idx] = (bf16_t)hi; dl[idx] = (bf16_t)(cvt_pk_bf16(v - bf_lo(hi), 0.f) & 0xffffu); } }
    { bf16_t* d = (bf16_t*)(wb + WB_WSP); const float* s = X.w_sp() + (size_t)l * 4 * CH * CH;
      for (int idx = gtid; idx < 4 * CH * CH; idx += gsz) { const int c = (idx >> 7) & 127, m = idx & 127; const float v = (m <= c) ? s[idx] : 0.f; d[idx] = (bf16_t)(cvt_pk_bf16(v, 0.f) & 0xffffu); } }
    { unsigned* d = (unsigned*)(wb + WB_WIN + (size_t)INW * D * 2);
      unsigned z = 0u; asm volatile("" : "+v"(z));
      for (int idx = gtid; idx < (INWP - INW) * D / 2; idx += gsz) d[idx] = z; }
}

__device__ __forceinline__ void phase_ada(const Ctx& X) {
    if (X.bx < 192) {
        LAS float* SC = (LAS float*)X.lds;
        for (int it = 0; it < 64; ++it) { const int idx = it * 512 + X.tid, b = idx & 31, k = idx >> 5; const float cv = X.c()[b * D + k]; SC[idx] = cv * fsigmoid(cv); }
        __syncthreads();
        const int la = X.bx / 48, n0 = (X.bx % 48) * 128, w = X.wid, ks = w >> 1, nh = w & 1;
        const float* wp = X.w_ada() + ((size_t)la * D + 256 * ks) * (6 * D) + n0 + 64 * nh + X.lane;
        float acc[32];
#pragma unroll
        for (int b = 0; b < 32; ++b) acc[b] = 0.f;
#pragma unroll 4
        for (int kk = 0; kk < 256; ++kk) {
            const float wv = wp[(size_t)kk * (6 * D)];
            const LAS f32x4* s4 = (const LAS f32x4*)(SC + (256 * ks + kk) * 32);
#pragma unroll
            for (int b4 = 0; b4 < 8; ++b4) { const f32x4 s = s4[b4];
#pragma unroll
                for (int q = 0; q < 4; ++q) acc[4 * b4 + q] += s[q] * wv; }
        }
        __syncthreads();
        LAS float* RED = (LAS float*)X.lds;
#pragma unroll
        for (int b = 0; b < 32; ++b) RED[(ks * 32 + b) * 128 + 64 * nh + X.lane] = acc[b];
        __syncthreads();
        float* ada = (float*)(X.ws + WS_ADA);
        for (int j = 0; j < 8; ++j) { const int idx = X.tid + 512 * j, b = idx >> 7, n = idx & 127; float s = X.b_ada()[la * 6 * D + n0 + n];
#pragma unroll
            for (int ww = 0; ww < 4; ++ww) s += RED[(ww * 32 + b) * 128 + n];
            ada[((size_t)la * NB + b) * (6 * D) + n0 + n] = s; }
        __syncthreads();
    }
    convert_layer_weights(X, 0, true);
}

__device__ __forceinline__ void phase_h0(const Ctx& X) {
    const float* ada = (const float*)(X.ws + WS_ADA);
    bf16_t* H = (bf16_t*)(X.ws + WS_H);
    for (size_t g8 = (size_t)X.bx * 512 + X.tid; g8 < (size_t)T * (D / 8); g8 += (size_t)X.G * 512) {
        const int t = (int)(g8 >> 7), c8 = (int)(g8 & 127) * 8, b = t >> 11;
        const float* xr = X.x() + (size_t)t * D + c8; const float* sh = ada + (size_t)b * 6 * D + c8; const float* sc = sh + D;
        const f32x4 x0 = *(const f32x4*)xr, x1 = *(const f32x4*)(xr + 4), s0 = *(const f32x4*)sh, s1 = *(const f32x4*)(sh + 4), c0 = *(const f32x4*)sc, c1 = *(const f32x4*)(sc + 4);
        const f32x4 h0 = x0 * (c0 + 1.0f) + s0, h1 = x1 * (c1 + 1.0f) + s1;
        u32x4 w; w.x = cvt_pk_bf16(h0[0], h0[1]); w.y = cvt_pk_bf16(h0[2], h0[3]); w.z = cvt_pk_bf16(h1[0], h1[1]); w.w = cvt_pk_bf16(h1[2], h1[3]);
        *(u32x4*)(H + (size_t)t * D + c8) = w;
        u32x4 xw; xw.x = cvt_pk_bf16(x0[0], x0[1]); xw.y = cvt_pk_bf16(x0[2], x0[3]); xw.z = cvt_pk_bf16(x1[0], x1[1]); xw.w = cvt_pk_bf16(x1[2], x1[3]);
        *(u32x4*)((bf16_t*)(X.ws + WS_X16) + (size_t)t * D + c8) = xw;
    }
}

__device__ __forceinline__ float log2gamma(int h) { return h == 0 ? -0.04580368961312479f : h == 1 ? -0.02272007650008353f : h == 2 ? -0.011315313227834146f : -0.005646563141142063f; }
constexpr int VT_PITCH = 288;
__device__ __forceinline__ int vt_sw(int row) { return ((row >> 2) ^ (row >> 4)) & 7; }
__device__ __forceinline__ int vt_elem(int row, int m) { return row * (VT_PITCH / 2) + ((((m >> 3) ^ vt_sw(row)) << 3) | (m & 7)); }
__device__ __forceinline__ int vt_byte(int row, int kc) { return row * VT_PITCH + ((kc ^ vt_sw(row)) << 4); }

__device__ __forceinline__ void rotary8(const u32x4& a, const u32x4& b, float pos, int i0, float scale, float (&o1)[8], float (&o2)[8]) {
    float t1[8] = {bf_lo(a.x), bf_hi(a.x), bf_lo(a.y), bf_hi(a.y), bf_lo(a.z), bf_hi(a.z), bf_lo(a.w), bf_hi(a.w)};
    float t2[8] = {bf_lo(b.x), bf_hi(b.x), bf_lo(b.y), bf_hi(b.y), bf_lo(b.z), bf_hi(b.z), bf_lo(b.w), bf_hi(b.w)};
#pragma unroll
    for (int j = 0; j < 8; ++j) {
        const float invf = exp2f(-(float)(i0 + j) * 0.8304820237218405f);
        const float rev = __builtin_amdgcn_fractf(pos * invf * 0.15915494309189535f); const float sn = __builtin_amdgcn_sinf(rev), cs = __builtin_amdgcn_cosf(rev);
        o1[j] = (t1[j] * cs - t2[j] * sn) * scale; o2[j] = (t2[j] * cs + t1[j] * sn) * scale;
    }
}

__device__ __forceinline__ void phase_mixA(const Ctx& X, int layer) {
    const bf16_t* P = (const bf16_t*)(X.ws + WS_R + R_P);
    bf16_t* BR = (bf16_t*)(X.ws + WS_R + R_BR);
    float* KV = (float*)(X.ws + WS_KV);
    LAS unsigned char* lds = X.lds;
    LAS bf16_t* KrT = (LAS bf16_t*)lds;
    LAS bf16_t* VT = (LAS bf16_t*)(lds + 128 * VT_PITCH);
    for (int u = X.bx; u < NB * NCH; u += X.G) {
        const int b = u >> 4, n = u & 15, t0 = b * SEQ + n * CH;
        const int tid = opaque_tid(X.wid), lane = tid & 63, w = X.wid, fr = lane & 15, fq = lane >> 4;
#pragma unroll
        for (int it = 0; it < 2; ++it) {
            const int id = it * 512 + tid, m = id >> 3, hg = id & 7, h = hg >> 1, g = hg & 1;
            const bf16_t* rp = P + (size_t)(t0 + m) * INWP + PC_RK + 32 * h + 8 * g;
            const u32x4 a = *(const u32x4*)rp, bb = *(const u32x4*)(rp + 16);
            const float pos = (float)X.pos()[t0 + m];
            const float zeta = exp2f(log2gamma(h) * (float)(CH - 1 - m)) * 0.1767766952966369f;
            float o1[8], o2[8]; rotary8(a, bb, pos, 8 * g, zeta, o1, o2);
#pragma unroll
            for (int j = 0; j < 8; ++j) { KrT[vt_elem(h * 32 + 8 * g + j, m)] = (bf16_t)(cvt_pk_bf16(o1[j], 0.f) & 0xffffu); KrT[vt_elem(h * 32 + 16 + 8 * g + j, m)] = (bf16_t)(cvt_pk_bf16(o2[j], 0.f) & 0xffffu); }
        }
#pragma unroll
        for (int it = 0; it < 8; ++it) {
            const int m = 32 * (it >> 1) + (tid >> 4), cg = (tid & 15) + 16 * (it & 1);
            const u32x4 a = *(const u32x4*)(P + (size_t)(t0 + m) * INWP + PC_RV + 8 * cg);
            const unsigned ww[4] = {a.x, a.y, a.z, a.w};
#pragma unroll
            for (int j = 0; j < 4; ++j) { VT[vt_elem(8 * cg + 2 * j, m)] = (bf16_t)(ww[j] & 0xffffu); VT[vt_elem(8 * cg + 2 * j + 1, m)] = (bf16_t)(ww[j] >> 16); }
        }
        __syncthreads();
        {
            const int h = w >> 1, it = w & 1;
            f32x4 acc[4];
#pragma unroll
            for (int jt = 0; jt < 4; ++jt) acc[jt] = (f32x4){0.f, 0.f, 0.f, 0.f};
#pragma unroll
            for (int ks = 0; ks < 4; ++ks) {
                const bf16x8 kf = *(const LAS bf16x8*)((LAS unsigned char*)KrT + vt_byte(h * 32 + 16 * it + fr, 4 * ks + fq));
#pragma unroll
                for (int jt = 0; jt < 4; ++jt) { const bf16x8 vf = *(const LAS bf16x8*)((LAS unsigned char*)VT + vt_byte(64 * h + 16 * jt + fr, 4 * ks + fq)); acc[jt] = MFMA16(kf, vf, acc[jt]); }
            }
            float* kvp = KV + ((size_t)(b * NCH + n) * 4 + h) * 2048;
#pragma unroll
            for (int jt = 0; jt < 4; ++jt) *(f32x4*)(kvp + (16 * jt + fr) * 32 + 16 * it + 4 * fq) = acc[jt];
        }
        {
            const int cg = tid & 31, seg = tid >> 5, c8 = 8 * cg;
            const float* cw = X.conv_w() + (size_t)layer * 3 * 256 + c8;
            float w0[8], w1[8], w2[8];
#pragma unroll
            for (int j = 0; j < 8; ++j) { w0[j] = cw[j]; w1[j] = cw[256 + j]; w2[j] = cw[512 + j]; }
            float z1[8], z2[8];
            const int s0 = n * CH + 8 * seg;
#pragma unroll
            for (int q = 0; q < 2; ++q) {
                const int sp = s0 - 2 + q; float zz[8];
                if (sp >= 0) { const bf16_t* rp = P + (size_t)(b * SEQ + sp) * INWP; const u32x4 cc = *(const u32x4*)(rp + PC_CC + c8), cx = *(const u32x4*)(rp + PC_CX + c8);
                    const unsigned c_[4] = {cc.x, cc.y, cc.z, cc.w}, x_[4] = {cx.x, cx.y, cx.z, cx.w};
#pragma unroll
                    for (int j = 0; j < 4; ++j) { zz[2 * j] = bf_lo(c_[j]) * bf_lo(x_[j]); zz[2 * j + 1] = bf_hi(c_[j]) * bf_hi(x_[j]); } }
                else {
#pragma unroll
                    for (int j = 0; j < 8; ++j) zz[j] = 0.f; }
#pragma unroll
                for (int j = 0; j < 8; ++j) { if (q == 0) z2[j] = zz[j]; else z1[j] = zz[j]; }
            }
            u32x4 cbv[8], ccv[8], cxv[8];
#pragma unroll
            for (int tt = 0; tt < 8; ++tt) { const bf16_t* rp = P + (size_t)(t0 + 8 * seg + tt) * INWP; cbv[tt] = __builtin_nontemporal_load((const u32x4*)(rp + PC_CB + c8)); ccv[tt] = __builtin_nontemporal_load((const u32x4*)(rp + PC_CC + c8)); cxv[tt] = __builtin_nontemporal_load((const u32x4*)(rp + PC_CX + c8)); }
#pragma unroll
            for (int tt = 0; tt < 8; ++tt) {
                const int t = t0 + 8 * seg + tt;
                const u32x4 cb = cbv[tt], cc = ccv[tt], cx = cxv[tt];
                const unsigned b_[4] = {cb.x, cb.y, cb.z, cb.w}, c_[4] = {cc.x, cc.y, cc.z, cc.w}, x_[4] = {cx.x, cx.y, cx.z, cx.w};
                float z0[8], o[8];
#pragma unroll
                for (int j = 0; j < 4; ++j) { z0[2 * j] = bf_lo(c_[j]) * bf_lo(x_[j]); z0[2 * j + 1] = bf_hi(c_[j]) * bf_hi(x_[j]); }
#pragma unroll
                for (int j = 0; j < 4; ++j) { o[2 * j] = bf_lo(b_[j]) * (w0[2 * j] * z2[2 * j] + w1[2 * j] * z1[2 * j] + w2[2 * j] * z0[2 * j]);
                    o[2 * j + 1] = bf_hi(b_[j]) * (w0[2 * j + 1] * z2[2 * j + 1] + w1[2 * j + 1] * z1[2 * j + 1] + w2[2 * j + 1] * z0[2 * j + 1]); }
                u32x4 ow; ow.x = cvt_pk_bf16(o[0], o[1]); ow.y = cvt_pk_bf16(o[2], o[3]); ow.z = cvt_pk_bf16(o[4], o[5]); ow.w = cvt_pk_bf16(o[6], o[7]);
                *(u32x4*)(BR + (size_t)t * 768 + 512 + c8) = ow;
#pragma unroll
                for (int j = 0; j < 8; ++j) { z2[j] = z1[j]; z1[j] = z0[j]; }
            }
        }
        __syncthreads();
    }
}

__device__ __forceinline__ void phase_mixB(const Ctx& X, int layer) {
    const bf16_t* P = (const bf16_t*)(X.ws + WS_R + R_P);
    bf16_t* BR = (bf16_t*)(X.ws + WS_R + R_BR);
    const float* KV = (const float*)(X.ws + WS_KV);
    const bf16_t* WSP = (const bf16_t*)(X.ws + WS_WB + WB_WSP);
    LAS unsigned char* lds = X.lds;
    constexpr int QL_P = 160, ST_P = 96;
    constexpr int OFF_QL = 0, OFF_KL = OFF_QL + 128 * QL_P, OFF_VT = OFF_KL + 128 * QL_P, OFF_STL = OFF_VT + 128 * VT_PITCH, OFF_PW = OFF_STL + 128 * ST_P;
    static_assert(OFF_PW + 8 * 16 * VT_PITCH <= LDS_MAIN, "mixB LDS");
    u32x4 pqa[2], pqb[2], pva[4], pgv[8];
#define MB_LOAD_PASS(pp, tb_) do { const int tl_ = opaque_tid(X.wid); const int m_ = tl_ >> 2, hg_ = tl_ & 3, h_ = 2 * (pp) + (hg_ >> 1), g_ = hg_ & 1; \
    _Pragma("unroll") for (int it = 0; it < 2; ++it) { const bf16_t* rp = P + (size_t)((tb_) + m_) * INWP + (it == 0 ? PC_RQ : PC_RK) + 32 * h_ + 8 * g_; \
        pqa[it] = __builtin_nontemporal_load((const u32x4*)rp); pqb[it] = __builtin_nontemporal_load((const u32x4*)(rp + 16)); } \
    _Pragma("unroll") for (int it = 0; it < 4; ++it) { const int id_ = it * 512 + tl_, m2_ = id_ >> 4, cg_ = id_ & 15; \
        pva[it] = __builtin_nontemporal_load((const u32x4*)(P + (size_t)((tb_) + m2_) * INWP + PC_RV + 128 * (pp) + 8 * cg_)); } } while (0)
    bool have = false;
    for (int uu = X.bx; uu < NB * NCH; uu += X.G) {
        const int u = (uu & 256) ? (uu ^ 15) : uu;
        const int b = u >> 4, n = u & 15, t0 = b * SEQ + n * CH;
        if (!have) MB_LOAD_PASS(0, t0);
        for (int p = 0; p < 2; ++p) {
            const int tid = opaque_tid(X.wid), lane = tid & 63, w = (X.wid < 4) ? X.wid : 11 - X.wid, fr = lane & 15, fq = lane >> 4;
#pragma unroll
            for (int it = 0; it < 2; ++it) {
                const int m = tid >> 2, hg = tid & 3, hh = hg >> 1, g = hg & 1, h = 2 * p + hh;
                const u32x4 a = pqa[it], bb = pqb[it];
                const float pos = (float)X.pos()[t0 + m];
                float o1[8], o2[8]; rotary8(a, bb, pos, 8 * g, it == 0 ? 1.0f : 0.1767766952966369f, o1, o2);
                u32x4 w1, w2; w1.x = cvt_pk_bf16(o1[0], o1[1]); w1.y = cvt_pk_bf16(o1[2], o1[3]); w1.z = cvt_pk_bf16(o1[4], o1[5]); w1.w = cvt_pk_bf16(o1[6], o1[7]);
                w2.x = cvt_pk_bf16(o2[0], o2[1]); w2.y = cvt_pk_bf16(o2[2], o2[3]); w2.z = cvt_pk_bf16(o2[4], o2[5]); w2.w = cvt_pk_bf16(o2[6], o2[7]);
                LAS unsigned char* dst = lds + (it == 0 ? OFF_QL : OFF_KL) + m * QL_P + (32 * hh + 8 * g) * 2;
                *(LAS u32x4*)dst = w1; *(LAS u32x4*)(dst + 32) = w2;
            }
#pragma unroll
            for (int it = 0; it < 4; ++it) {
                const int id = it * 512 + tid, m = id >> 4, cg = id & 15;
                const u32x4 a = pva[it];
                const unsigned ww[4] = {a.x, a.y, a.z, a.w};
                LAS bf16_t* vt = (LAS bf16_t*)(lds + OFF_VT);
#pragma unroll
                for (int j = 0; j < 4; ++j) { vt[vt_elem(8 * cg + 2 * j, m)] = (bf16_t)(ww[j] & 0xffffu); vt[vt_elem(8 * cg + 2 * j + 1, m)] = (bf16_t)(ww[j] >> 16); }
            }
            {
                const int q4a = tid * 2, dvl = q4a >> 3, dk4 = q4a & 7, h = 2 * p + (dvl >> 6);
                const float lgc = log2gamma(h) * 128.0f;
                const float* kvb = KV + ((size_t)(b * NCH) * 4 + h) * 2048 + (dvl & 63) * 32 + 4 * dk4;
                f32x4 s0 = (f32x4){0.f, 0.f, 0.f, 0.f}, s1 = s0;
#pragma unroll
                for (int jb = 0; jb < 16; jb += 8) {
                    if (jb < n) {
                        f32x4 k0[8], k1[8];
#pragma unroll
                        for (int jj = 0; jj < 8; ++jj) { const int j = jb + jj; const int jc = j < n ? j : 0; k0[jj] = *(const f32x4*)(kvb + (size_t)jc * 4 * 2048); k1[jj] = *(const f32x4*)(kvb + (size_t)jc * 4 * 2048 + 4); }
#pragma unroll
                        for (int jj = 0; jj < 8; ++jj) { const int j = jb + jj; const float wj = j < n ? exp2f(lgc * (float)(n - 1 - j)) : 0.f; s0 += k0[jj] * wj; s1 += k1[jj] * wj; }
                    }
                }
                u32x4 o; o.x = cvt_pk_bf16(s0[0], s0[1]); o.y = cvt_pk_bf16(s0[2], s0[3]); o.z = cvt_pk_bf16(s1[0], s1[1]); o.w = cvt_pk_bf16(s1[2], s1[3]);
                *(LAS u32x4*)(lds + OFF_STL + dvl * ST_P + 8 * dk4) = o;
            }
            __syncthreads();
            if (p == 0) MB_LOAD_PASS(1, t0);
            else {
                const int tg_ = opaque_tid(X.wid);
#pragma unroll
                for (int i = 0; i < 8; ++i) pgv[i] = *(const u32x4*)(P + (size_t)(t0 + (tg_ >> 2)) * INWP + PC_GV + 8 * (4 * i + (tg_ & 3)));
            }
            for (int hh = 0; hh < 2; ++hh) {
                const int h = 2 * p + hh; const float lg2 = log2gamma(h);
                const bf16x8 qf = *(const LAS bf16x8*)(lds + OFF_QL + (16 * w + fr) * QL_P + (32 * hh + 8 * fq) * 2);
                LAS unsigned char* pw = lds + OFF_PW + w * 16 * VT_PITCH;
                u32x2 gwv[4];
#pragma unroll
                for (int jt = 0; jt < 4; ++jt) gwv[jt] = __builtin_nontemporal_load((const u32x2*)(P + (size_t)(t0 + 16 * w + fr) * INWP + PC_RG + 64 * h + 16 * jt + 4 * fq));
                float lf[4];
#pragma unroll
                for (int r = 0; r < 4; ++r) lf[r] = __builtin_amdgcn_exp2f(lg2 * (float)(fr - 4 * fq - r));
#pragma unroll
                for (int mb = 0; mb < 8; ++mb) {
                    if (mb <= w) {
                        const bf16x8 kf = *(const LAS bf16x8*)(lds + OFF_KL + (16 * mb + fr) * QL_P + (32 * hh + 8 * fq) * 2);
                        const f32x4 s = MFMA16(kf, qf, ((f32x4){0.f, 0.f, 0.f, 0.f}));
                        const float bsc = __builtin_amdgcn_exp2f(lg2 * (float)(16 * (w - mb)));
                        float v[4];
#pragma unroll
                        for (int r = 0; r < 4; ++r) { const int d = (16 * w + fr) - (16 * mb + 4 * fq + r); v[r] = d >= 0 ? s[r] * (bsc * lf[r]) : 0.f; }
                        u32x2 o; o.x = cvt_pk_bf16(v[0], v[1]); o.y = cvt_pk_bf16(v[2], v[3]);
                        *(LAS u32x2*)(pw + fr * VT_PITCH + (16 * mb + 4 * fq) * 2) = o;
                    } else if (mb == w + 1 && (w & 1) == 0) {
                        *(LAS u32x2*)(pw + fr * VT_PITCH + (16 * mb + 4 * fq) * 2) = (u32x2){0u, 0u};
                    }
                }
                WAIT_L0(); __builtin_amdgcn_wave_barrier();
                f32x4 ao[4], ax[4];
#pragma unroll
                for (int jt = 0; jt < 4; ++jt) { ao[jt] = (f32x4){0.f, 0.f, 0.f, 0.f}; ax[jt] = (f32x4){0.f, 0.f, 0.f, 0.f}; }
                const int nks = (w >> 1) + 1;
#pragma unroll
                for (int ks = 0; ks < 4; ++ks) {
                    if (ks < nks) {
                        const bf16x8 pf = *(const LAS bf16x8*)(pw + fr * VT_PITCH + (32 * ks + 8 * fq) * 2);
#pragma unroll
                        for (int jt = 0; jt < 4; ++jt) { const bf16x8 vf = *(const LAS bf16x8*)(lds + OFF_VT + vt_byte(64 * hh + 16 * jt + fr, 4 * ks + fq)); ao[jt] = MFMA16(vf, pf, ao[jt]); }
                    }
                }
#pragma unroll
                for (int jt = 0; jt < 4; ++jt) { const bf16x8 sf = *(const LAS bf16x8*)(lds + OFF_STL + (64 * hh + 16 * jt + fr) * ST_P + 8 * fq * 2); ax[jt] = MFMA16(sf, qf, ax[jt]); }
                const int cl = 16 * w + fr; const float xi = exp2f(lg2 * (float)(cl + 1));
                float o[4][4]; float sum = 0.f;
#pragma unroll
                for (int jt = 0; jt < 4; ++jt)
#pragma unroll
                    for (int r = 0; r < 4; ++r) { o[jt][r] = ao[jt][r] + xi * ax[jt][r]; sum += o[jt][r]; }
                sum += __shfl_xor(sum, 16); sum += __shfl_xor(sum, 32);
                const float mu = sum * (1.0f / 64.0f); float sq = 0.f;
#pragma unroll
                for (int jt = 0; jt < 4; ++jt)
#pragma unroll
                    for (int r = 0; r < 4; ++r) { const float d = o[jt][r] - mu; sq += d * d; }
                sq += __shfl_xor(sq, 16); sq += __shfl_xor(sq, 32);
                const float rstd = rsqrtf(sq * (1.0f / 64.0f) + LN_EPS);
                const size_t t = (size_t)(t0 + cl);
#pragma unroll
                for (int jt = 0; jt < 4; ++jt) {
                    const u32x2 gw = gwv[jt];
                    const float gg[4] = {bf_lo(gw.x), bf_hi(gw.x), bf_lo(gw.y), bf_hi(gw.y)}; float r4[4];
#pragma unroll
                    for (int r = 0; r < 4; ++r) r4[r] = gg[r] * fsigmoid(gg[r]) * ((o[jt][r] - mu) * rstd);
                    u32x2 ow; ow.x = cvt_pk_bf16(r4[0], r4[1]); ow.y = cvt_pk_bf16(r4[2], r4[3]);
                    *(u32x2*)(BR + t * 768 + 64 * h + 16 * jt + 4 * fq) = ow;
                }
                WAIT_L0(); __builtin_amdgcn_wave_barrier();
            }
            __syncthreads();
        }
        {
            const int tid = opaque_tid(X.wid);
            LAS bf16_t* vt2 = (LAS bf16_t*)lds;
            const int m = tid >> 2, qd = tid & 3; const size_t t = (size_t)(t0 + m);
            float sum = 0.f, sq = 0.f;
            float gv[8][8];
#pragma unroll
            for (int i = 0; i < 8; ++i) {
                const u32x4 a = pgv[i];
                const unsigned ww[4] = {a.x, a.y, a.z, a.w};
#pragma unroll
                for (int j = 0; j < 4; ++j) { const float v0 = gelu_tanh(bf_lo(ww[j])), v1 = gelu_tanh(bf_hi(ww[j])); gv[i][2 * j] = v0; gv[i][2 * j + 1] = v1; sum += v0 + v1; sq += v0 * v0 + v1 * v1; }
            }
            DPP_ADD(sum, 0xB1, 0xf); DPP_ADD(sum, 0x4E, 0xf); DPP_ADD(sq, 0xB1, 0xf); DPP_ADD(sq, 0x4E, 0xf);
            const float mu = sum * (1.0f / 256.0f); const float var = fmaxf(sq * (1.0f / 256.0f) - mu * mu, 0.f);
            const float rstd = rsqrtf(var + LN_EPS);
            const float* lg_ = X.gln_g() + layer * 256; const float* lb_ = X.gln_b() + layer * 256;
#pragma unroll
            for (int i = 0; i < 8; ++i) {
                const int c0 = 8 * (4 * i + qd);
                const f32x4 lga = *(const f32x4*)(lg_ + c0), lgb = *(const f32x4*)(lg_ + c0 + 4), lba = *(const f32x4*)(lb_ + c0), lbb = *(const f32x4*)(lb_ + c0 + 4);
                const float lgv[8] = {lga[0], lga[1], lga[2], lga[3], lgb[0], lgb[1], lgb[2], lgb[3]}, lbv[8] = {lba[0], lba[1], lba[2], lba[3], lbb[0], lbb[1], lbb[2], lbb[3]};
#pragma unroll
                for (int j = 0; j < 4; ++j) {
                    const float v0 = (gv[i][2 * j] - mu) * rstd * lgv[2 * j] + lbv[2 * j], v1 = (gv[i][2 * j + 1] - mu) * rstd * lgv[2 * j + 1] + lbv[2 * j + 1];
                    const unsigned pk = cvt_pk_bf16(v0, v1);
                    vt2[vt_elem(c0 + 2 * j, m)] = (bf16_t)(pk & 0xffffu); vt2[vt_elem(c0 + 2 * j + 1, m)] = (bf16_t)(pk >> 16);
                }
                if (i & 1) __builtin_amdgcn_sched_barrier(0);
            }
        }
        __syncthreads();
        {
            const int tid = opaque_tid(X.wid), lane = tid & 63, w = (X.wid < 4) ? X.wid : 11 - X.wid, fr = lane & 15, fq = lane >> 4;
            const int nks = (w >> 1) + 1; const int cl = 16 * w + fr; const size_t t = (size_t)(t0 + cl);
            { const int un_ = uu + X.G; have = un_ < NB * NCH; if (have) { const int u2_ = (un_ & 256) ? (un_ ^ 15) : un_; MB_LOAD_PASS(0, (u2_ >> 4) * SEQ + (u2_ & 15) * CH); } }
            bf16x8 wfa[4][4]; u32x2 uwa[4][4];
#pragma unroll
            for (int g = 0; g < 4; ++g) {
#pragma unroll
                for (int ks = 0; ks < 4; ++ks) wfa[g][ks] = *(const bf16x8*)(WSP + ((size_t)g * CH + cl) * CH + 32 * (ks < nks ? ks : 0) + 8 * fq);
#pragma unroll
                for (int jt = 0; jt < 4; ++jt) uwa[g][jt] = __builtin_nontemporal_load((const u32x2*)(P + t * INWP + PC_GU + 64 * g + 16 * jt + 4 * fq));
            }
#pragma unroll
            for (int g = 0; g < 4; ++g) {
                f32x4 acc[4];
#pragma unroll
                for (int jt = 0; jt < 4; ++jt) acc[jt] = (f32x4){0.f, 0.f, 0.f, 0.f};
#pragma unroll
                for (int ks = 0; ks < 4; ++ks) {
                    if (ks < nks) {
                        const bf16x8 wf = wfa[g][ks];
#pragma unroll
                        for (int jt = 0; jt < 4; ++jt) { const bf16x8 vf = *(const LAS bf16x8*)(lds + vt_byte(64 * g + 16 * jt + fr, 4 * ks + fq)); acc[jt] = MFMA16(vf, wf, acc[jt]); }
                    }
                }
                const float bs = X.b_sp()[(size_t)layer * 4 * CH + g * CH + cl];
#pragma unroll
                for (int jt = 0; jt < 4; ++jt) {
                    const u32x2 uw = uwa[g][jt];
                    const float uu[4] = {bf_lo(uw.x), bf_hi(uw.x), bf_lo(uw.y), bf_hi(uw.y)}; float r4[4];
#pragma unroll
                    for (int r = 0; r < 4; ++r) r4[r] = gelu_tanh(uu[r]) * (acc[jt][r] + bs);
                    u32x2 ow; ow.x = cvt_pk_bf16(r4[0], r4[1]); ow.y = cvt_pk_bf16(r4[2], r4[3]);
                    *(u32x2*)(BR + t * 768 + 256 + 64 * g + 16 * jt + 4 * fq) = ow;
                }
            }
        }
        __syncthreads();
    }
#undef MB_LOAD_PASS
}

__device__ __forceinline__ void phase_ln1(const Ctx& X, int layer) {
    bf16_t* X16 = (bf16_t*)(X.ws + WS_X16);
    const bf16_t* MIX = (const bf16_t*)(X.ws + WS_R + R_MIX);
    bf16_t* H = (bf16_t*)(X.ws + WS_H);
    const bf16_t* WRT = (const bf16_t*)(X.ws + WS_WB + WB_WRT); const bf16_t* WRTL = (const bf16_t*)(X.ws + WS_WB + WB_WRTL);
    const float* ada = (const float*)(X.ws + WS_ADA) + (size_t)layer * NB * 6 * D;
    unsigned* cntg = (unsigned*)(X.ws + WS_CTRL + CTRL_CNT) + layer * 32;
    int* toklist = (int*)(X.ws + WS_TOKL); float* wlist = (float*)(X.ws + WS_WL); unsigned* topi = (unsigned*)(X.ws + WS_TOPI);
    LAS unsigned char* lds = X.lds;
    constexpr int HL_P = 2064;
    constexpr int OFF_HL = 0, OFF_LG = OFF_HL + 16 * HL_P, OFF_AE = OFF_LG + 8 * 16 * 32 * 4, OFF_AR = OFF_AE + 1024 * 4, OFF_AW = OFF_AR + 1024 * 4, OFF_HIST = OFF_AW + 1024 * 4, OFF_BASE = OFF_HIST + 128, OFF_CST = OFF_BASE + 128, OFF_HL2 = OFF_CST + 5 * D * 4, OFF_LGT = OFF_HL2 + 16 * HL_P;
    LAS float* CST = (LAS float*)(lds + OFF_CST);
    LAS float* LG = (LAS float*)(lds + OFF_LG); LAS float* LGT = (LAS float*)(lds + OFF_LGT);
    static_assert(OFF_LGT + 256 * 33 * 4 <= LDS_XB, "ln1 LDS (runs into the table area behind LDS_MAIN, which LN1 does not use)");
    LAS int* AE = (LAS int*)(lds + OFF_AE); LAS int* AR = (LAS int*)(lds + OFF_AR); LAS float* AW = (LAS float*)(lds + OFF_AW);
    LAS int* HIST = (LAS int*)(lds + OFF_HIST); LAS int* BASE = (LAS int*)(lds + OFF_BASE);
    const int tid = X.tid, lane = X.lane, w = X.wid, fr = lane & 15, fq = lane >> 4;
    for (int blk = X.bx; blk < T / 256; blk += X.G) {
        const int tb0 = blk * 256, b = tb0 >> 11;
        if (tid < 32) HIST[tid] = 0;
        for (int i = tid; i < 5 * D; i += 512) { const int v = i >> 10, col = i & 1023; float val;
            if (v == 0) val = 1.0f + ada[(size_t)b * 6 * D + 2 * D + col]; else if (v == 1) val = 1.0f + ada[(size_t)b * 6 * D + 4 * D + col]; else if (v == 2) val = ada[(size_t)b * 6 * D + 3 * D + col];
            else if (v == 3) val = X.ln1_g()[layer * D + col]; else val = X.ln1_b()[layer * D + col];
            CST[i] = val; }
        __syncthreads();
        bf16x8 rw0[4], rw1[4], rl0[4], rl1[4];
#pragma unroll
        for (int ks = 0; ks < 4; ++ks) { const int k0 = 128 * w + 32 * ks + 8 * fq;
            rw0[ks] = *(const bf16x8*)(WRT + (size_t)fr * D + k0); rw1[ks] = *(const bf16x8*)(WRT + (size_t)(16 + fr) * D + k0);
            rl0[ks] = *(const bf16x8*)(WRTL + (size_t)fr * D + k0); rl1[ks] = *(const bf16x8*)(WRTL + (size_t)(16 + fr) * D + k0); }
        const float brt_e = X.b_rt()[layer * NE + (opaque_tid(w) & 31)];
        u32x4 cxr[2][2], cmr[2][2], nxr[2][2], nmr[2][2];
#define LN1_LOAD2(xx, mm, st_) do { _Pragma("unroll") for (int q = 0; q < 2; ++q) { const size_t _t = (size_t)(tb0 + 16 * (st_) + 2 * w + q); _Pragma("unroll") for (int hf = 0; hf < 2; ++hf) { \
            xx[q][hf] = __builtin_nontemporal_load((const u32x4*)(X16 + _t * D + 512 * hf + 8 * lane)); mm[q][hf] = __builtin_nontemporal_load((const u32x4*)(MIX + _t * D + 512 * hf + 8 * lane)); } } } while (0)
        LN1_LOAD2(cxr, cmr, 0);
#pragma nounroll
        for (int st = 0; st < 16; ++st) {
            { const int stn = st < 15 ? st + 1 : 15; LN1_LOAD2(nxr, nmr, stn); }
#pragma unroll
            for (int q = 0; q < 2; ++q) {
                const int tl = 2 * w + q; const size_t t = (size_t)(tb0 + 16 * st + tl);
                float v[16];
#pragma unroll
                for (int hf = 0; hf < 2; ++hf) {
                    const int col = 512 * hf + 8 * lane;
                    const u32x4 xw = cxr[q][hf]; const f32x4 x0 = (f32x4){bf_lo(xw.x), bf_hi(xw.x), bf_lo(xw.y), bf_hi(xw.y)}, x1 = (f32x4){bf_lo(xw.z), bf_hi(xw.z), bf_lo(xw.w), bf_hi(xw.w)};
                    const u32x4 mw = cmr[q][hf];
                    const f32x4 g0 = *(const LAS f32x4*)(CST + col), g1 = *(const LAS f32x4*)(CST + col + 4);
                    const float mm[8] = {bf_lo(mw.x), bf_hi(mw.x), bf_lo(mw.y), bf_hi(mw.y), bf_lo(mw.z), bf_hi(mw.z), bf_lo(mw.w), bf_hi(mw.w)};
#pragma unroll
                    for (int j = 0; j < 4; ++j) { v[8 * hf + j] = DN_ALPHA * x0[j] + g0[j] * mm[j]; v[8 * hf + 4 + j] = DN_ALPHA * x1[j] + g1[j] * mm[4 + j]; }
                }
                float s = 0.f;
#pragma unroll
                for (int j = 0; j < 16; ++j) s += v[j];
                const float mu = wave_sum(s) * (1.0f / 1024.0f); float sq = 0.f;
#pragma unroll
                for (int j = 0; j < 16; ++j) { const float d = v[j] - mu; sq += d * d; }
                const float rstd = rsqrtf(wave_sum(sq) * (1.0f / 1024.0f) + LN_EPS);
#pragma unroll
                for (int hf = 0; hf < 2; ++hf) {
                    const int col = 512 * hf + 8 * lane; float h2[8]; f32x4 xs[2];
#pragma unroll
                    for (int q4 = 0; q4 < 2; ++q4) {
                        const f32x4 lg4 = *(const LAS f32x4*)(CST + 3 * D + col + 4 * q4), lb4 = *(const LAS f32x4*)(CST + 4 * D + col + 4 * q4);
                        const f32x4 sc4 = *(const LAS f32x4*)(CST + D + col + 4 * q4), sh4 = *(const LAS f32x4*)(CST + 2 * D + col + 4 * q4);
                        f32x4 xo;
#pragma unroll
                        for (int j = 0; j < 4; ++j) { xo[j] = (v[8 * hf + 4 * q4 + j] - mu) * rstd * lg4[j] + lb4[j]; h2[4 * q4 + j] = xo[j] * sc4[j] + sh4[j]; }
                        xs[q4] = xo;
                    }
                    { u32x4 xw; xw.x = cvt_pk_bf16(xs[0][0], xs[0][1]); xw.y = cvt_pk_bf16(xs[0][2], xs[0][3]); xw.z = cvt_pk_bf16(xs[1][0], xs[1][1]); xw.w = cvt_pk_bf16(xs[1][2], xs[1][3]); *(u32x4*)(X16 + t * D + col) = xw; }
                    u32x4 hw; hw.x = cvt_pk_bf16(h2[0], h2[1]); hw.y = cvt_pk_bf16(h2[2], h2[3]); hw.z = cvt_pk_bf16(h2[4], h2[5]); hw.w = cvt_pk_bf16(h2[6], h2[7]);
                    *(u32x4*)(H + t * D + col) = hw;
                    *(LAS u32x4*)(lds + OFF_HL + tl * HL_P + col * 2) = hw;
                    u32x4 lw; lw.x = cvt_pk_bf16(h2[0] - bf_lo(hw.x), h2[1] - bf_hi(hw.x)); lw.y = cvt_pk_bf16(h2[2] - bf_lo(hw.y), h2[3] - bf_hi(hw.y)); lw.z = cvt_pk_bf16(h2[4] - bf_lo(hw.z), h2[5] - bf_hi(hw.z)); lw.w = cvt_pk_bf16(h2[6] - bf_lo(hw.w), h2[7] - bf_hi(hw.w));
                    *(LAS u32x4*)(lds + OFF_HL2 + tl * HL_P + col * 2) = lw;
                }
            }
            __syncthreads();
            {
                f32x4 a0 = (f32x4){0.f, 0.f, 0.f, 0.f}, a1 = a0;
#pragma unroll
                for (int ks = 0; ks < 4; ++ks) {
                    const int k0 = 128 * w + 32 * ks + 8 * fq;
                    const bf16x8 hf_ = *(const LAS bf16x8*)(lds + OFF_HL + fr * HL_P + k0 * 2), hl_ = *(const LAS bf16x8*)(lds + OFF_HL2 + fr * HL_P + k0 * 2);
                    a0 = MFMA16(rl0[ks], hf_, a0); a1 = MFMA16(rl1[ks], hf_, a1); a0 = MFMA16(rw0[ks], hl_, a0); a1 = MFMA16(rw1[ks], hl_, a1); a0 = MFMA16(rw0[ks], hf_, a0); a1 = MFMA16(rw1[ks], hf_, a1);
                }
                *(LAS f32x4*)(LG + (w * 16 + fr) * 32 + 4 * fq) = a0; *(LAS f32x4*)(LG + (w * 16 + fr) * 32 + 16 + 4 * fq) = a1;
            }
            __syncthreads();
            {
                const int tk = tid >> 5, e = tid & 31; float s = brt_e;
#pragma unroll
                for (int ww = 0; ww < 8; ++ww) s += LG[(ww * 16 + tk) * 32 + e];
                LGT[(16 * st + tk) * 33 + e] = s;
            }
#pragma unroll
            for (int q = 0; q < 2; ++q)
#pragma unroll
                for (int hf = 0; hf < 2; ++hf) { cxr[q][hf] = nxr[q][hf]; cmr[q][hf] = nmr[q][hf]; }
        }
#undef LN1_LOAD2
        __syncthreads();
        if (tid < 256) {
            LAS float* row = LGT + tid * 33;
            float bv[4]; int bi[4];
#pragma unroll
            for (int k = 0; k < 4; ++k) {
                float best = -3.0e38f; int be = 0;
#pragma unroll 8
                for (int e = 0; e < 32; ++e) { const float vv = row[e]; if (vv > best) { best = vv; be = e; } }
                bv[k] = best; bi[k] = be; row[be] = -3.0e38f;
            }
            const float e1 = __expf(bv[1] - bv[0]), e2 = __expf(bv[2] - bv[0]), e3 = __expf(bv[3] - bv[0]); const float inv = 1.0f / (1.0f + e1 + e2 + e3);
            const float ww[4] = {inv, e1 * inv, e2 * inv, e3 * inv};
#pragma unroll
            for (int k = 0; k < 4; ++k) { const int a = tid * 4 + k; AE[a] = bi[k]; AW[a] = ww[k]; AR[a] = __hip_atomic_fetch_add(HIST + bi[k], 1, __ATOMIC_RELAXED, __HIP_MEMORY_SCOPE_WORKGROUP); }
        }
        __syncthreads();
        { const int t2 = opaque_tid(w); if (t2 < 32) BASE[t2] = (int)__hip_atomic_fetch_add(cntg + t2, (unsigned)HIST[t2], __ATOMIC_RELAXED, __HIP_MEMORY_SCOPE_AGENT); }
        __syncthreads();
#pragma unroll
        for (int q = 0; q < 2; ++q) {
            const int a = tid + 512 * q, e = AE[a], pos = BASE[e] + AR[a], tok = tb0 + (a >> 2);
            toklist[e * 65536 + pos] = tok; wlist[e * 65536 + pos] = AW[a]; topi[(size_t)tok * 4 + (a & 3)] = ((unsigned)e << 16) | (unsigned)pos;
        }
        __syncthreads();
    }
}

__device__ __forceinline__ void phase_ln2(const Ctx& X, int layer) {
    const bf16_t* OUT = (const bf16_t*)(X.ws + WS_R + R_OUT);
    bf16_t* H = (bf16_t*)(X.ws + WS_H);
    const float* ada = (const float*)(X.ws + WS_ADA) + (size_t)layer * NB * 6 * D;
    const float* adan = ada + (size_t)NB * 6 * D;
    const unsigned* topi = (const unsigned*)(X.ws + WS_TOPI);
    const LAS int* tb = (const LAS int*)(X.lds + LDS_TB); bf16_t* X16 = (bf16_t*)(X.ws + WS_X16);
    LAS float* CST = (LAS float*)X.lds;
    const bool last = (layer == NL - 1);
    for (int blk = X.bx; blk < T / 256; blk += X.G) {
        const int tid = opaque_tid(X.wid), lane = tid & 63, w = X.wid;
        const int tb0 = blk * 256, b = tb0 >> 11;
        __syncthreads();
        for (int i = tid; i < 5 * D; i += 512) { const int v = i >> 10, col = i & 1023; float val;
            if (v == 0) val = 1.0f + ada[(size_t)b * 6 * D + 5 * D + col]; else if (v == 1) val = last ? 1.0f : 1.0f + adan[(size_t)b * 6 * D + D + col]; else if (v == 2) val = last ? 0.f : adan[(size_t)b * 6 * D + col];
            else if (v == 3) val = X.ln2_g()[layer * D + col]; else val = X.ln2_b()[layer * D + col];
            CST[i] = val; }
        __syncthreads();
        {
            const size_t tw = (size_t)(tb0 + 32 * w);
            u32x4 oa[8], ob[8]; f32x4 xa[4], xb[4];
            f32x4 cg[4], clg[4], clb[4], csc[4], csh[4];
#pragma unroll
            for (int hf = 0; hf < 2; ++hf)
#pragma unroll
                for (int q4 = 0; q4 < 2; ++q4) { const int col = 512 * hf + 8 * lane + 4 * q4; cg[2 * hf + q4] = *(const LAS f32x4*)(CST + col); csc[2 * hf + q4] = *(const LAS f32x4*)(CST + D + col); csh[2 * hf + q4] = *(const LAS f32x4*)(CST + 2 * D + col);
                    clg[2 * hf + q4] = *(const LAS f32x4*)(CST + 3 * D + col); clb[2 * hf + q4] = *(const LAS f32x4*)(CST + 4 * D + col); }
#define LN2_LOAD(oo, xx, ti_, tt) do { const size_t _t = (tt); const unsigned _tv[4] = {ti_.x, ti_.y, ti_.z, ti_.w}; \
            _Pragma("unroll") for (int k = 0; k < 4; ++k) { const size_t _row = (size_t)(tb[32 + (int)(_tv[k] >> 16)] + (int)(_tv[k] & 0xffffu)); \
                oo[2 * k] = __builtin_nontemporal_load((const u32x4*)(OUT + _row * D + 8 * lane)); oo[2 * k + 1] = __builtin_nontemporal_load((const u32x4*)(OUT + _row * D + 512 + 8 * lane)); } \
            _Pragma("unroll") for (int hf = 0; hf < 2; ++hf) { const u32x4 _xw = __builtin_nontemporal_load((const u32x4*)(X16 + _t * D + 512 * hf + 8 * lane)); xx[2 * hf] = (f32x4){bf_lo(_xw.x), bf_hi(_xw.x), bf_lo(_xw.y), bf_hi(_xw.y)}; xx[2 * hf + 1] = (f32x4){bf_lo(_xw.z), bf_hi(_xw.z), bf_lo(_xw.w), bf_hi(_xw.w)}; } } while (0)
            u32x4 tiB = *(const u32x4*)(topi + tw * 4);
            LN2_LOAD(oa, xa, tiB, tw);
            tiB = *(const u32x4*)(topi + (tw + 1) * 4);
#pragma nounroll
            for (int q = 0; q < 32; ++q) {
                const size_t t = tw + q;
                const u32x4 tiC = *(const u32x4*)(topi + (tw + (q + 2 < 32 ? q + 2 : 31)) * 4);
                { const size_t tn = tw + (q + 1 < 32 ? q + 1 : 31); LN2_LOAD(ob, xb, tiB, tn); }
                float y[16];
#pragma unroll
                for (int j = 0; j < 16; ++j) y[j] = 0.f;
#pragma unroll
                for (int k = 0; k < 4; ++k)
#pragma unroll
                    for (int hf = 0; hf < 2; ++hf) { const u32x4 ow = oa[2 * k + hf];
                        y[8 * hf] += bf_lo(ow.x); y[8 * hf + 1] += bf_hi(ow.x); y[8 * hf + 2] += bf_lo(ow.y); y[8 * hf + 3] += bf_hi(ow.y);
                        y[8 * hf + 4] += bf_lo(ow.z); y[8 * hf + 5] += bf_hi(ow.z); y[8 * hf + 6] += bf_lo(ow.w); y[8 * hf + 7] += bf_hi(ow.w); }
                float v[16];
#pragma unroll
                for (int hf = 0; hf < 2; ++hf) { const int col = 512 * hf + 8 * lane;
                    const f32x4 x0 = xa[2 * hf], x1 = xa[2 * hf + 1];
                    const f32x4 g0 = cg[2 * hf], g1 = cg[2 * hf + 1];
#pragma unroll
                    for (int j = 0; j < 4; ++j) { v[8 * hf + j] = DN_ALPHA * x0[j] + g0[j] * y[8 * hf + j]; v[8 * hf + 4 + j] = DN_ALPHA * x1[j] + g1[j] * y[8 * hf + 4 + j]; } }
                float s = 0.f;
#pragma unroll
                for (int j = 0; j < 16; ++j) s += v[j];
                const float mu = wave_sum(s) * (1.0f / 1024.0f); float sq = 0.f;
#pragma unroll
                for (int j = 0; j < 16; ++j) { const float d = v[j] - mu; sq += d * d; }
                const float rstd = rsqrtf(wave_sum(sq) * (1.0f / 1024.0f) + LN_EPS);
#pragma unroll
                for (int hf = 0; hf < 2; ++hf) { const int col = 512 * hf + 8 * lane; float h[8]; f32x4 xs[2];
#pragma unroll
                    for (int q4 = 0; q4 < 2; ++q4) {
                        const f32x4 lg4 = clg[2 * hf + q4], lb4 = clb[2 * hf + q4], sc4 = csc[2 * hf + q4], sh4 = csh[2 * hf + q4];
                        f32x4 xo;
#pragma unroll
                        for (int j = 0; j < 4; ++j) { xo[j] = (v[8 * hf + 4 * q4 + j] - mu) * rstd * lg4[j] + lb4[j]; h[4 * q4 + j] = xo[j] * sc4[j] + sh4[j]; }
                        if (last) *(f32x4*)(X.out + t * D + col + 4 * q4) = xo;
                        xs[q4] = xo;
                    }
                    if (!last) { u32x4 xw; xw.x = cvt_pk_bf16(xs[0][0], xs[0][1]); xw.y = cvt_pk_bf16(xs[0][2], xs[0][3]); xw.z = cvt_pk_bf16(xs[1][0], xs[1][1]); xw.w = cvt_pk_bf16(xs[1][2], xs[1][3]); *(u32x4*)(X16 + t * D + col) = xw; }
                    if (!last) { u32x4 hw; hw.x = cvt_pk_bf16(h[0], h[1]); hw.y = cvt_pk_bf16(h[2], h[3]); hw.z = cvt_pk_bf16(h[4], h[5]); hw.w = cvt_pk_bf16(h[6], h[7]);
                        *(u32x4*)(H + t * D + col) = hw; } }
#pragma unroll
                for (int i = 0; i < 8; ++i) oa[i] = ob[i];
#pragma unroll
                for (int i = 0; i < 4; ++i) xa[i] = xb[i];
                tiB = tiC;
            }
#undef LN2_LOAD
        }
    }
    __syncthreads();
    if (!last) convert_layer_weights(X, layer + 1, false);
}

constexpr int PH_PER_LAYER = 9, N_PHASES = 2 + NL * PH_PER_LAYER;

__global__ void __launch_bounds__(512, 2) mega_fwd(Args args) {
    extern __shared__ __attribute__((aligned(16))) unsigned char lds_raw[];
    Ctx X;
    X.ka = (KArgsPtr)__builtin_amdgcn_kernarg_segment_ptr();
    X.out = args.out; X.ws = args.ws; X.lds = (LAS unsigned char*)lds_raw;
    X.wid = __builtin_amdgcn_readfirstlane((int)threadIdx.x >> 6); X.tid = opaque_tid(X.wid); X.lane = X.tid & 63; X.G = gridDim.x; X.bx = blockIdx.x;

    if (X.tid < 16) ((LAS unsigned*)(X.lds + LDS_XB))[X.tid] = 0u;
    __syncthreads();
    const int lo = args.ph_lo, hi = args.ph_hi;
    XcdBarrier bar; bar.bar = (unsigned*)(X.ws + WS_CTRL); bar.x = 0; bar.st = (volatile LAS unsigned*)(X.lds + LDS_XB);
    if (hi - lo > 1) bar = xcd_barrier_post((unsigned*)(X.ws + WS_CTRL), (volatile LAS unsigned*)(X.lds + LDS_XB), X.tid == 0);
#define IN(k) (lo <= (k) && (k) < hi)
#define SEAM(k) do { if (IN((k) + 1)) xcd_barrier(bar, opaque_tid(X.wid) == 0); } while (0)

    if (IN(0)) { refresh(X); phase_ada(X); SEAM(0); }
    if (IN(1)) { refresh(X); phase_h0(X); SEAM(1); }
    for (int l = 0; l < NL; ++l) {
        const int pb = 2 + l * PH_PER_LAYER;
        if (IN(pb + 0)) {
            refresh(X);
            ProbDense8<16> pr; pr.init(X, X.ws + WS_H, X.ws + WS_WB + WB_WIN, (bf16_t*)(X.ws + WS_R + R_P), INWP, INWP / 256, T / 256); pr.ncv = INW;
            gemm8_run<ProbDense8<16>, true>(X, pr); SEAM(pb + 0);
        }
        if (IN(pb + 1)) { refresh(X); phase_mixA(X, l); SEAM(pb + 1); }
        if (IN(pb + 2)) { refresh(X); phase_mixB(X, l); SEAM(pb + 2); }
        if (IN(pb + 3)) { refresh(X); ProbMG pr; pr.init(X, l); merge_run(X, pr); SEAM(pb + 3); }
        if (IN(pb + 4)) {
            refresh(X);
            ProbDense8<16> pr; pr.init(X, X.ws + WS_R + R_MG, X.ws + WS_WB + WB_WOUT, (bf16_t*)(X.ws + WS_R + R_MIX), D, D / 256, T / 256);
            gemm8_run<ProbDense8<16>, true>(X, pr); SEAM(pb + 4);
        }
        if (IN(pb + 5)) { refresh(X); phase_ln1(X, l); SEAM(pb + 5); }
        if (IN(pb + 6)) { refresh(X); moe_tables(X, l); ProbGU8 pr; pr.init(X, l); gemm8_run<ProbGU8, true>(X, pr);
            if (l < NL - 1) { int uu; if (!sched_unit(X, last_round(X, pr.nunits()), pr.nunits(), uu)) convert_early(X, l + 1, CVT_EARLY_GU); }
            SEAM(pb + 6); }
        if (IN(pb + 7)) { refresh(X); moe_tables(X, l); ProbDN8 pr; pr.init(X, l); gemm8_run<ProbDN8, true>(X, pr);
            if (l < NL - 1) { int uu; if (!sched_unit(X, last_round(X, pr.nunits()), pr.nunits(), uu)) convert_early(X, l + 1, CVT_EARLY_DN); }
            SEAM(pb + 7); }
        if (IN(pb + 8)) { refresh(X); moe_tables(X, l); phase_ln2(X, l); if (l < NL - 1) SEAM(pb + 8); }
    }
#undef IN
#undef SEAM
}

extern "C" void kernel_launch(void* const* d_in, const int* in_sizes, int n_in, void* d_out, int out_size, void* d_ws, size_t ws_size, hipStream_t stream) {
    static int grid = 0;
    if (grid == 0) {
        if (n_in != 25 || out_size != T * D || ws_size < WS_END) { fprintf(stderr, "kernel_launch: unexpected shapes (n_in %d, out %d, ws %zu < %zu); nothing launched\n", n_in, out_size, ws_size, (size_t)WS_END); grid = -1; return; }
        int dev = 0, cus = 0, per_cu = 0;
        if (hipGetDevice(&dev) != hipSuccess || hipDeviceGetAttribute(&cus, hipDeviceAttributeMultiprocessorCount, dev) != hipSuccess) { grid = -1; return; }
        if (hipFuncSetAttribute((const void*)mega_fwd, hipFuncAttributeMaxDynamicSharedMemorySize, LDS_BYTES) != hipSuccess) { fprintf(stderr, "kernel_launch: hipFuncSetAttribute failed\n"); grid = -1; return; }
        if (hipOccupancyMaxActiveBlocksPerMultiprocessor(&per_cu, (const void*)mega_fwd, 512, LDS_BYTES) != hipSuccess || per_cu < 1) { fprintf(stderr, "kernel_launch: occupancy query says %d blocks per CU\n", per_cu); per_cu = 1; }
        (void)hipGetLastError();
        grid = cus;
    }
    if (grid < 0) return;
    (void)hipMemsetAsync((char*)d_ws + WS_CTRL, 0, CTRL_BYTES, stream);
    Args a{};
    for (int i = 0; i < 25; ++i) a.in[i] = d_in[i];
    a.out = (float*)d_out; a.ws = (unsigned char*)d_ws;
#if MK_N_LAUNCHES == 1
    a.ph_lo = 0; a.ph_hi = N_PHASES;
    hipLaunchKernelGGL(mega_fwd, dim3(grid), dim3(512), LDS_BYTES, stream, a);
#else
    for (int p = 0; p < N_PHASES; ++p) { a.ph_lo = p; a.ph_hi = p + 1; hipLaunchKernelGGL(mega_fwd, dim3(grid), dim3(512), LDS_BYTES, stream, a); }
#endif
}
```
